# Optimizing an MI355X kernel written in HIP

```python
import jax, jax.numpy as jnp
from jax import lax
import numpy as np

D_MODEL = 1024
BATCH = 4
SEQ = 4096
DEPTH = 1

D_MIX = D_MODEL
D_FOX = D_MIX // 2
D_RET = D_MIX - D_FOX
FOX_HEADS = 8
FOX_HEAD_DIM = D_FOX // FOX_HEADS
RET_HEADS = 4
RET_HEAD_DIM = D_RET // RET_HEADS
D_FF = 2816
BLOCK_Q = 128
RET_CHUNK = 128
ROPE_BASE = 10000.0
LN_EPS = 1e-5
N_MOD = 9
DEEPNORM_ALPHA = (2.0 * DEPTH) ** 0.25
DEEPNORM_BETA = (8.0 * DEPTH) ** -0.25
FFN_RES_WEIGHT = 0.5
SPLITS = [D_FOX, 2 * D_FOX, 3 * D_FOX, 3 * D_FOX + FOX_HEADS,
          3 * D_FOX + FOX_HEADS + D_RET, 3 * D_FOX + FOX_HEADS + 2 * D_RET,
          3 * D_FOX + FOX_HEADS + 3 * D_RET]
D_IN_PROJ = 3 * D_FOX + FOX_HEADS + 4 * D_RET

kernel_name = "fox_retnet_hymba_macaron_deepnorm_adaln"


def _layer_norm(x, g, b):
    xf = x.astype(jnp.float32)
    mu = xf.mean(-1, keepdims=True)
    var = jnp.square(xf - mu).mean(-1, keepdims=True)
    return ((xf - mu) * lax.rsqrt(var + LN_EPS)).astype(x.dtype) * g + b


def _modulate(x, shift, scale):
    return x * (1.0 + scale[:, None, :]) + shift[:, None, :]


def _swiglu(h, w_gate, w_up, w_down):
    return (jax.nn.silu(h @ w_gate) * (h @ w_up)) @ w_down


def _heads(t, n_heads):
    B, S, _ = t.shape
    return t.reshape(B, S, n_heads, -1).transpose(0, 2, 1, 3)


def _merge_heads(t):
    B, H, S, Dh = t.shape
    return t.transpose(0, 2, 1, 3).reshape(B, S, H * Dh)


def _rotary(t):
    S, Dk = t.shape[2], t.shape[3]
    half = Dk // 2
    inv_freq = ROPE_BASE ** (-jnp.arange(half, dtype=jnp.float32) / half)
    ang = jnp.arange(S, dtype=jnp.float32)[:, None] * inv_freq[None, :]
    cos = jnp.cos(ang).astype(t.dtype)
    sin = jnp.sin(ang).astype(t.dtype)
    t1, t2 = t[..., :half], t[..., half:]
    return jnp.concatenate([t1 * cos - t2 * sin, t1 * sin + t2 * cos], axis=-1)


def _forgetting_attention(q, k, v, log_f):
    B, H, S, Dh = q.shape
    cum = jnp.cumsum(log_f, axis=-1)
    scale = Dh ** -0.5
    kpos = jnp.arange(S)
    n_blocks = S // BLOCK_Q

    def one_block(i):
        start = i * BLOCK_Q
        qb = lax.dynamic_slice_in_dim(q, start, BLOCK_Q, axis=2)
        cb = lax.dynamic_slice_in_dim(cum, start, BLOCK_Q, axis=2)
        s = jnp.einsum('bhqd,bhkd->bhqk', qb, k).astype(jnp.float32) * scale
        s = s + cb[..., :, None] - cum[..., None, :]
        qpos = start + jnp.arange(BLOCK_Q)
        s = jnp.where(kpos[None, :] <= qpos[:, None], s, -jnp.inf)
        p = jax.nn.softmax(s, axis=-1).astype(v.dtype)
        return jnp.einsum('bhqk,bhkd->bhqd', p, v)

    out = lax.map(one_block, jnp.arange(n_blocks))
    return out.transpose(1, 2, 0, 3, 4).reshape(B, H, S, Dh)


def _retention_chunkwise(q, k, v):
    B, H, S, Dk = q.shape
    Dv = v.shape[-1]
    C = RET_CHUNK
    n = S // C
    log_gamma = jnp.log1p(-jnp.power(2.0, -5.0 - jnp.arange(H, dtype=jnp.float32)))
    idx = jnp.arange(C, dtype=jnp.float32)
    diff = idx[:, None] - idx[None, :]
    intra_decay = jnp.where(diff >= 0,
                            jnp.exp(log_gamma[:, None, None] * jnp.maximum(diff, 0.0)), 0.0)
    q_decay = jnp.exp(log_gamma[:, None] * (idx + 1.0))[..., None]
    k_decay = jnp.exp(log_gamma[:, None] * (C - 1.0 - idx))[..., None]
    chunk_decay = jnp.exp(log_gamma * C)[:, None, None]

    def to_chunks(t):
        return t.reshape(B, H, n, C, t.shape[-1]).transpose(2, 0, 1, 3, 4)

    def step(state, inp):
        qi, ki, vi = inp
        s = jnp.einsum('bhid,bhjd->bhij', qi, ki) * intra_decay
        o = jnp.einsum('bhij,bhjv->bhiv', s, vi) + jnp.einsum('bhid,bhdv->bhiv', qi * q_decay, state)
        new_state = state * chunk_decay + jnp.einsum('bhjd,bhjv->bhdv', ki * k_decay, vi)
        return new_state, o

    state0 = jnp.zeros((B, H, Dk, Dv), jnp.float32)
    _, out = lax.scan(step, state0, (to_chunks(q), to_chunks(k), to_chunks(v)))
    return out.transpose(1, 2, 0, 3, 4).reshape(B, H, S, Dv).astype(v.dtype)


def _group_norm_heads(y, g, b):
    yf = y.astype(jnp.float32)
    mu = yf.mean(-1, keepdims=True)
    var = jnp.square(yf - mu).mean(-1, keepdims=True)
    yn = ((yf - mu) * lax.rsqrt(var + LN_EPS)).astype(y.dtype)
    return _merge_heads(yn) * g + b


def _hybrid_mixer(h, w_in, fox_b_f, ret_gn_g, ret_gn_b, w_o):
    proj = h @ w_in
    fq, fk, fv, fl, rq, rk, rv, rg = jnp.split(proj, SPLITS, axis=-1)
    log_f = jax.nn.log_sigmoid(fl.astype(jnp.float32) + fox_b_f.astype(jnp.float32))
    log_f = log_f.transpose(0, 2, 1)
    fox = _forgetting_attention(_heads(fq, FOX_HEADS), _heads(fk, FOX_HEADS),
                                _heads(fv, FOX_HEADS), log_f)
    fox = _merge_heads(fox)
    q_r = _rotary(_heads(rq, RET_HEADS))
    k_r = _rotary(_heads(rk, RET_HEADS)) * (RET_HEAD_DIM ** -0.5)
    ret = _retention_chunkwise(q_r, k_r, _heads(rv, RET_HEADS))
    ret = jax.nn.silu(rg) * _group_norm_heads(ret, ret_gn_g, ret_gn_b)
    return jnp.concatenate([fox, ret], axis=-1) @ w_o


def setup_inputs(seed: int = 0) -> dict:
    key = jax.random.key(seed)
    ks = jax.random.split(key, 24)
    f32 = jnp.float32
    L, D = DEPTH, D_MODEL

    def nrm(k, shape, scale):
        return jax.random.normal(k, shape, f32) * scale

    x = jax.random.normal(ks[0], (BATCH, SEQ, D), f32)
    c = jax.random.normal(ks[1], (BATCH, D), f32)
    w_ada = nrm(ks[2], (L, D, N_MOD * D), 0.5 * D ** -0.5)
    b_ada = nrm(ks[3], (L, N_MOD * D), 0.02)

    def ffn(k):
        k1, k2, k3 = jax.random.split(k, 3)
        return (nrm(k1, (L, D, D_FF), D ** -0.5),
                nrm(k2, (L, D, D_FF), D ** -0.5),
                nrm(k3, (L, D_FF, D), DEEPNORM_BETA * D_FF ** -0.5))

    ffn1_w_gate, ffn1_w_up, ffn1_w_down = ffn(ks[4])
    ffn2_w_gate, ffn2_w_up, ffn2_w_down = ffn(ks[5])

    def ln(k):
        k1, k2 = jax.random.split(k)
        return 1.0 + nrm(k1, (L, D), 0.02), nrm(k2, (L, D), 0.02)

    ln1_g, ln1_b = ln(ks[6])
    ln2_g, ln2_b = ln(ks[7])
    ln3_g, ln3_b = ln(ks[8])

    s_in = D ** -0.5
    w_in = jnp.concatenate([
        nrm(ks[9], (L, D, D_FOX), s_in),
        nrm(ks[10], (L, D, D_FOX), s_in),
        nrm(ks[11], (L, D, D_FOX), DEEPNORM_BETA * s_in),
        nrm(ks[12], (L, D, FOX_HEADS), s_in),
        nrm(ks[13], (L, D, D_RET), s_in),
        nrm(ks[14], (L, D, D_RET), s_in),
        nrm(ks[15], (L, D, D_RET), DEEPNORM_BETA * s_in),
        nrm(ks[16], (L, D, D_RET), s_in),
    ], axis=-1)
    fox_b_f = 1.0 + 2.0 * jax.random.uniform(ks[17], (L, FOX_HEADS), f32)
    ret_gn_g = 1.0 + nrm(ks[18], (L, D_RET), 0.02)
    ret_gn_b = nrm(ks[19], (L, D_RET), 0.02)
    w_o = nrm(ks[20], (L, D_MIX, D), DEEPNORM_BETA * D_MIX ** -0.5)

    return {"x": x, "c": c, "w_ada": w_ada, "b_ada": b_ada,
            "ffn1_w_gate": ffn1_w_gate, "ffn1_w_up": ffn1_w_up, "ffn1_w_down": ffn1_w_down,
            "ln1_g": ln1_g, "ln1_b": ln1_b,
            "w_in": w_in, "fox_b_f": fox_b_f, "ret_gn_g": ret_gn_g, "ret_gn_b": ret_gn_b,
            "w_o": w_o, "ln2_g": ln2_g, "ln2_b": ln2_b,
            "ffn2_w_gate": ffn2_w_gate, "ffn2_w_up": ffn2_w_up, "ffn2_w_down": ffn2_w_down,
            "ln3_g": ln3_g, "ln3_b": ln3_b}


def reference(x, c, w_ada, b_ada,
              ffn1_w_gate, ffn1_w_up, ffn1_w_down, ln1_g, ln1_b,
              w_in, fox_b_f, ret_gn_g, ret_gn_b, w_o, ln2_g, ln2_b,
              ffn2_w_gate, ffn2_w_up, ffn2_w_down, ln3_g, ln3_b):
    c_act = jax.nn.silu(c)
    for l in range(DEPTH):
        mod = c_act @ w_ada[l] + b_ada[l]
        sh1, sc1, g1, sh2, sc2, g2, sh3, sc3, g3 = jnp.split(mod, N_MOD, axis=-1)
        h = _modulate(x, sh1, sc1)
        f = _swiglu(h, ffn1_w_gate[l], ffn1_w_up[l], ffn1_w_down[l])
        x = _layer_norm(DEEPNORM_ALPHA * x + FFN_RES_WEIGHT * g1[:, None, :] * f, ln1_g[l], ln1_b[l])
        h = _modulate(x, sh2, sc2)
        m = _hybrid_mixer(h, w_in[l], fox_b_f[l], ret_gn_g[l], ret_gn_b[l], w_o[l])
        x = _layer_norm(DEEPNORM_ALPHA * x + g2[:, None, :] * m, ln2_g[l], ln2_b[l])
        h = _modulate(x, sh3, sc3)
        f = _swiglu(h, ffn2_w_gate[l], ffn2_w_up[l], ffn2_w_down[l])
        x = _layer_norm(DEEPNORM_ALPHA * x + FFN_RES_WEIGHT * g3[:, None, :] * f, ln3_g[l], ln3_b[l])
    return x
```

```cpp
#include <hip/hip_runtime.h>
#include <hip/hip_cooperative_groups.h>
#include <cstdio>
#include <cstdint>
#include <cmath>
namespace cg = cooperative_groups;
namespace pg8 {
#define PG8_LAS __attribute__((address_space(3)))
typedef unsigned short bf16_t;
typedef short bf16x8 __attribute__((ext_vector_type(8)));
typedef float f32x4 __attribute__((ext_vector_type(4)));
typedef unsigned u32x4 __attribute__((ext_vector_type(4)));
constexpr int BM = 256, BK = 64, HALF = 128, HTB = HALF * BK * 2  , STAGE_BYTES = 8 * HTB, NXCD = 8, WGM = 8;

__host__ __device__ __forceinline__ int lds_byte(int r, int c) { const int st = (r >> 4) * 2 + (c >> 5), rr = r & 15, cc = c & 31, ob = rr * 64 + cc * 2; return st * 1024 + (ob ^ (((ob >> 9) & 1) << 5)); }
__host__ __device__ __forceinline__ void stage_rc(int b, int& R, int& C) { const int st = b / 1024, sb = b % 1024, swz = sb ^ (((sb >> 9) & 1) << 5); R = (st >> 1) * 16 + swz / 64; C = (st & 1) * 32 + (swz % 64) / 2; }
__host__ __device__ __forceinline__ int perm32(int rho) { const int n = rho >> 4, i = rho & 15; return 8 * (i >> 2) + 4 * n + (i & 3); }

struct Unit { int pm, pn; };
struct Gemm { const bf16_t* A; const bf16_t* Bt; int M, N, K; };

struct StaticOrder {
    int nM, nN, nwg, G, c;
    __host__ __device__ void init(int M, int N, int G_, int c_) { nM = M / BM; nN = N / BM; nwg = nM * nN; G = G_; c = c_; }
    __host__ __device__ bool next(int i, Unit& u) const {
        const long L = (long)i * G + c; if (L >= nwg) return false;
        int wgid = (int)L; { const int q = nwg / NXCD, r = nwg % NXCD, xcd = wgid % NXCD, off = wgid / NXCD; wgid = (xcd < r ? xcd * (q + 1) : r * (q + 1) + (xcd - r) * q) + off; }
        const int nig = WGM * nN, gid = wgid / nig, fm = gid * WGM, gsz = (nM - fm) < WGM ? (nM - fm) : WGM;
        u.pm = fm + ((wgid % nig) % gsz); u.pn = (wgid % nig) / gsz; return true;
    }
    __device__ __forceinline__ void a_ready(const Unit&) const {}
    __device__ __forceinline__ void done(const Unit&) const {}
};

__device__ __forceinline__ unsigned cvt_pk_bf16(float lo, float hi) { unsigned r; asm volatile("v_cvt_pk_bf16_f32 %0, %1, %2" : "=v"(r) : "v"(lo), "v"(hi)); return r; }
typedef float f32x2 __attribute__((ext_vector_type(2)));
typedef unsigned u32x2 __attribute__((ext_vector_type(2)));
__device__ __forceinline__ float silu_f(float g) { return g * __builtin_amdgcn_rcpf(1.0f + __builtin_amdgcn_exp2f(-1.4426950408889634f * g)); }

struct EpiSwiglu {
    static constexpr bool PERM = true, AFTER_DRAIN = false;
    bf16_t* O; int ldc;
    __device__ __forceinline__ void operator()(const f32x4 (&acc)[2][2][4][2], const Unit& u, int wr, int wc, int fr, int fq) const {
        const int row0 = u.pm * BM + wr * 64 + fr, col0 = u.pn * HALF + wc * 32 + 8 * fq;
#pragma unroll
        for (int ai = 0; ai < 2; ++ai)
#pragma unroll
            for (int m = 0; m < 4; ++m) {
                bf16_t* rowp = O + (size_t)(row0 + ai * HALF + m * 16) * ldc + col0;
                const f32x4 g0 = acc[ai][0][m][0], g1 = acc[ai][0][m][1], u0 = acc[ai][1][m][0], u1 = acc[ai][1][m][1];
                u32x4 w;
                w.x = cvt_pk_bf16(silu_f(g0[0]) * u0[0], silu_f(g0[1]) * u0[1]); w.y = cvt_pk_bf16(silu_f(g0[2]) * u0[2], silu_f(g0[3]) * u0[3]);
                w.z = cvt_pk_bf16(silu_f(g1[0]) * u1[0], silu_f(g1[1]) * u1[1]); w.w = cvt_pk_bf16(silu_f(g1[2]) * u1[2], silu_f(g1[3]) * u1[3]);
                *(u32x4*)rowp = w;
            }
    }
};

struct EpiResid {
    static constexpr bool PERM = false, AFTER_DRAIN = false;
    const float* xin; float* out; const float* gmod; float alpha, coef; int seq, modstride;
    __device__ __forceinline__ void operator()(const f32x4 (&acc)[2][2][4][2], const Unit& u, int wr, int wc, int fr, int fq) const {
        const int row0 = u.pm * BM + wr * 64 + fr, col0 = u.pn * BM + wc * 32 + 4 * fq;
        const float* gp = gmod + (size_t)((u.pm * BM) / seq) * modstride;
#pragma unroll
        for (int bj = 0; bj < 2; ++bj)
#pragma unroll
            for (int n = 0; n < 2; ++n) {
                const f32x4 gv = *(const f32x4*)(gp + col0 + bj * HALF + n * 16) * coef;
#pragma unroll
                for (int ai = 0; ai < 2; ++ai)
#pragma unroll
                    for (int m = 0; m < 4; ++m) {
                        const size_t off = (size_t)(row0 + ai * HALF + m * 16) * 1024 + col0 + bj * HALF + n * 16;
                        const f32x4 xv = *(const f32x4*)(xin + off);
                        *(f32x4*)(out + off) = xv * alpha + gv * acc[ai][bj][m][n];
                    }
            }
    }
};

struct EpiInProj {
    static constexpr bool PERM = true, AFTER_DRAIN = false;
    bf16_t *FQ, *FK, *FVT, *RQ, *RK, *RKT, *RVT, *RG; const float* ROT; float lg0, lg1, lg2v, lg3;
    __device__ __forceinline__ void operator()(const f32x4 (&acc)[2][2][4][2], const Unit& u, int wr, int wc, int fr, int fq) const {
        const int t = u.pn >> 1, sub = u.pn & 1;
        const int row0 = u.pm * BM + wr * 64 + fr;
        const int b = (u.pm * BM) >> 12, s0 = (u.pm * BM) & 4095;
        if (t == 0 || t == 1 || t == 6) {
            bf16_t* base = (t == 0) ? FQ : (t == 1) ? FK : RG;
            const float sc = (t == 0) ? 0.125f * 1.4426950408889634f : 1.0f;
            const int col0 = sub * BM + wc * 32 + 8 * fq;
#pragma unroll
            for (int ai = 0; ai < 2; ++ai)
#pragma unroll
                for (int m = 0; m < 4; ++m) { bf16_t* rowp = base + (size_t)(row0 + ai * HALF + m * 16) * 512 + col0;
#pragma unroll
                    for (int bj = 0; bj < 2; ++bj) { f32x4 v0 = acc[ai][bj][m][0], v1 = acc[ai][bj][m][1];
                        if (t == 6) { v0 = (f32x4){silu_f(v0[0]), silu_f(v0[1]), silu_f(v0[2]), silu_f(v0[3])}; v1 = (f32x4){silu_f(v1[0]), silu_f(v1[1]), silu_f(v1[2]), silu_f(v1[3])}; }
                        else { v0 = v0 * sc; v1 = v1 * sc; }
                        u32x4 w; w.x = cvt_pk_bf16(v0[0], v0[1]); w.y = cvt_pk_bf16(v0[2], v0[3]); w.z = cvt_pk_bf16(v1[0], v1[1]); w.w = cvt_pk_bf16(v1[2], v1[3]);
                        *(u32x4*)(rowp + bj * HALF) = w; } }
        } else if (t == 2 || t == 5) {
            bf16_t* base = (t == 2) ? FVT : RVT;
#pragma unroll
            for (int bj = 0; bj < 2; ++bj) {
                const int c0 = sub * BM + bj * HALF + wc * 32 + 8 * fq;
                bf16_t* cp = base + ((size_t)b * 512 + c0) * 4096 + s0 + wr * 64 + fr;
#pragma unroll
                for (int ai = 0; ai < 2; ++ai)
#pragma unroll
                    for (int m = 0; m < 4; ++m) { bf16_t* p = cp + ai * HALF + m * 16;
#pragma unroll
                        for (int n = 0; n < 2; ++n) { const f32x4 v = acc[ai][bj][m][n];
                            const unsigned w0 = cvt_pk_bf16(v[0], v[1]), w1 = cvt_pk_bf16(v[2], v[3]);
                            p[(size_t)(4 * n + 0) * 4096] = (bf16_t)(w0 & 0xffffu); p[(size_t)(4 * n + 1) * 4096] = (bf16_t)(w0 >> 16);
                            p[(size_t)(4 * n + 2) * 4096] = (bf16_t)(w1 & 0xffffu); p[(size_t)(4 * n + 3) * 4096] = (bf16_t)(w1 >> 16); } }
            }
        } else {
            const bool isk = (t == 4);
            const float sc = isk ? 0.08838834764831845f : 1.0f;
            bf16_t* base = isk ? RK : RQ;
            const int d0 = 16 * wc + 4 * fq;
#pragma unroll
            for (int bj = 0; bj < 2; ++bj) {
                const int hh = 2 * sub + bj;
                const float lg2 = (hh == 0) ? lg0 : (hh == 1) ? lg1 : (hh == 2) ? lg2v : lg3;
#pragma unroll
                for (int ai = 0; ai < 2; ++ai)
#pragma unroll
                    for (int m = 0; m < 4; ++m) {
                        const int sl = wr * 64 + ai * HALF + m * 16 + fr, s = s0 + sl;
                        const f32x4 r0 = *(const f32x4*)(ROT + ((size_t)s * 64 + d0) * 2), r1 = *(const f32x4*)(ROT + ((size_t)s * 64 + d0) * 2 + 4);
                        const f32x4 v0 = acc[ai][bj][m][0] * sc, v1 = acc[ai][bj][m][1] * sc;
                        float a[4], c[4];
                        a[0] = v0[0] * r0[0] - v0[1] * r0[1]; c[0] = v0[0] * r0[1] + v0[1] * r0[0];
                        a[1] = v0[2] * r0[2] - v0[3] * r0[3]; c[1] = v0[2] * r0[3] + v0[3] * r0[2];
                        a[2] = v1[0] * r1[0] - v1[1] * r1[1]; c[2] = v1[0] * r1[1] + v1[1] * r1[0];
                        a[3] = v1[2] * r1[2] - v1[3] * r1[3]; c[3] = v1[2] * r1[3] + v1[3] * r1[2];
                        bf16_t* rowp = base + (size_t)(u.pm * BM + sl) * 512 + hh * 128 + d0;
                        u32x2 w; w.x = cvt_pk_bf16(a[0], a[1]); w.y = cvt_pk_bf16(a[2], a[3]); *(u32x2*)rowp = w;
                        w.x = cvt_pk_bf16(c[0], c[1]); w.y = cvt_pk_bf16(c[2], c[3]); *(u32x2*)(rowp + 64) = w;
                        if (isk) {
                            const float dec = __builtin_amdgcn_exp2f(lg2 * (float)(127 - (s & 127)));
                            bf16_t* p = RKT + ((size_t)(b * 4 + hh) * 128 + d0) * 4096 + s;
                            const unsigned x0 = cvt_pk_bf16(a[0] * dec, a[1] * dec), x1 = cvt_pk_bf16(a[2] * dec, a[3] * dec);
                            const unsigned y0 = cvt_pk_bf16(c[0] * dec, c[1] * dec), y1 = cvt_pk_bf16(c[2] * dec, c[3] * dec);
                            p[0] = (bf16_t)(x0 & 0xffffu); p[4096] = (bf16_t)(x0 >> 16); p[2 * 4096] = (bf16_t)(x1 & 0xffffu); p[3 * 4096] = (bf16_t)(x1 >> 16);
                            p += (size_t)64 * 4096;
                            p[0] = (bf16_t)(y0 & 0xffffu); p[4096] = (bf16_t)(y0 >> 16); p[2 * 4096] = (bf16_t)(y1 & 0xffffu); p[3 * 4096] = (bf16_t)(y1 >> 16);
                        }
                    }
            }
        }
    }
};
template <class Epi, class Sched, bool ALIGN_EPI = false, bool SP2 = false>
__device__ __forceinline__ void gemm_phase(PG8_LAS unsigned char* lds, const Gemm g, const Sched& S, const Epi& E) {
    const int tid = threadIdx.x, wid = __builtin_amdgcn_readfirstlane(tid >> 6), lane = tid & 63, wr = wid >> 2, wc = wid & 3, fr = lane & 15, fq = lane >> 4;
    const int K = g.K, nt = K / BK;
    unsigned voffA[2], voffB[2];
#pragma unroll
    for (int i = 0; i < 2; ++i) { int R, C; stage_rc(tid * 16 + i * 8192, R, C); const int Rb = Epi::PERM ? ((R & ~31) + perm32(R & 31)) : R;
        voffA[i] = (unsigned)(R * K + C) * 2u; voffB[i] = (unsigned)(Rb * K + C) * 2u; }
    const size_t kstep = (size_t)(BK * 2);
    const size_t hstep = (size_t)HALF * K * 2;
    const size_t tstep = 2 * hstep;
    const unsigned ldsw = (unsigned)wid * 1024u;
    const int aoff = lds_byte(wr * 64 + fr, fq * 8), boff = lds_byte(wc * 32 + fr, fq * 8);
#define PG8_SA(b, h) (((b) * 2 + (h)) * HTB)
#define PG8_SB(b, h) ((4 + (b) * 2 + (h)) * HTB)
#define PG8_STAGE(bufoff, gbase, voff) do { _Pragma("unroll") for (int _i = 0; _i < 2; ++_i) \
        __builtin_amdgcn_global_load_lds((const unsigned*)((const char*)(gbase) + (voff)[_i]), (PG8_LAS unsigned*)(lds + (bufoff) + ldsw + _i * 8192), 16, 0, 0); } while (0)
#define PG8_LDA(dst, b, h) do { _Pragma("unroll") for (int m = 0; m < 4; ++m) _Pragma("unroll") for (int k = 0; k < 2; ++k) dst[m][k] = *(const PG8_LAS bf16x8*)(lds + PG8_SA(b, h) + aoff + m * 2048 + k * 1024); } while (0)
#define PG8_LDB(dst, b, h) do { _Pragma("unroll") for (int n = 0; n < 2; ++n) _Pragma("unroll") for (int k = 0; k < 2; ++k) dst[n][k] = *(const PG8_LAS bf16x8*)(lds + PG8_SB(b, h) + boff + n * 2048 + k * 1024); } while (0)
#define PG8_MMA(ai, bj, At, Bt) do { __builtin_amdgcn_s_setprio(1); _Pragma("unroll") for (int m = 0; m < 4; ++m) _Pragma("unroll") for (int n = 0; n < 2; ++n) _Pragma("unroll") for (int k = 0; k < 2; ++k) \
        acc[ai][bj][m][n] = __builtin_amdgcn_mfma_f32_16x16x32_bf16(Bt[n][k], At[m][k], acc[ai][bj][m][n], 0, 0, 0); __builtin_amdgcn_s_setprio(0); } while (0)
#define PG8_WAIT_V(n) asm volatile("s_waitcnt vmcnt(" #n ")" ::: "memory")
#define PG8_WAIT_L(n) asm volatile("s_waitcnt lgkmcnt(" #n ")" ::: "memory")
#define PG8_BAR __builtin_amdgcn_s_barrier()
#define PG8_SCHED __builtin_amdgcn_sched_barrier(0)
    Unit cur, nxt; int ui = 0;
    if (!S.next(0, cur)) return;
    f32x4 acc[2][2][4][2];
#pragma unroll
    for (int a = 0; a < 2; ++a)
#pragma unroll
        for (int b = 0; b < 2; ++b)
#pragma unroll
            for (int m = 0; m < 4; ++m)
#pragma unroll
                for (int n = 0; n < 2; ++n) acc[a][b][m][n] = (f32x4){0.f, 0.f, 0.f, 0.f};
    bf16x8 At[4][2], B0[2][2], B1[2][2];
    const char* cA = (const char*)g.A + (size_t)cur.pm * tstep; const char* cB = (const char*)g.Bt + (size_t)cur.pn * tstep;
    S.a_ready(cur);
    if constexpr (SP2) {
        PG8_STAGE(PG8_SB(0, 0), cB, voffB); PG8_STAGE(PG8_SB(0, 1), cB + hstep, voffB); PG8_STAGE(PG8_SA(0, 0), cA, voffA); PG8_STAGE(PG8_SA(0, 1), cA + hstep, voffA);
        if (wr == 1) PG8_BAR;
        PG8_WAIT_V(2); PG8_BAR;
        PG8_STAGE(PG8_SB(1, 0), cB + kstep, voffB); PG8_STAGE(PG8_SA(1, 0), cA + kstep, voffA); PG8_STAGE(PG8_SB(1, 1), cB + hstep + kstep, voffB);
        PG8_WAIT_V(6); PG8_BAR;
    } else {
        PG8_STAGE(PG8_SB(0, 0), cB, voffB); PG8_STAGE(PG8_SA(0, 0), cA, voffA); PG8_STAGE(PG8_SB(0, 1), cB + hstep, voffB); PG8_STAGE(PG8_SA(0, 1), cA + hstep, voffA);
        if (wr == 1) PG8_BAR;
        PG8_WAIT_V(4); PG8_BAR;
        PG8_STAGE(PG8_SB(1, 0), cB + kstep, voffB); PG8_STAGE(PG8_SA(1, 0), cA + kstep, voffA); PG8_STAGE(PG8_SB(1, 1), cB + hstep + kstep, voffB);
        PG8_WAIT_V(6); PG8_BAR;
    }
    for (;;) {
        const bool has_next = S.next(ui + 1, nxt);
        const char* nA = has_next ? (const char*)g.A + (size_t)nxt.pm * tstep : cA; const char* nB = has_next ? (const char*)g.Bt + (size_t)nxt.pn * tstep : cB;
        for (int t = 0; t < nt; t += 2) {
            const bool last = (t == nt - 2);
            const char* a1 = cA + (size_t)(t + 1) * kstep;
            const char* a2 = last ? nA : cA + (size_t)(t + 2) * kstep; const char* b2 = last ? nB : cB + (size_t)(t + 2) * kstep;
            const char* a3 = a2 + kstep; const char* b3 = b2 + kstep;
            if (last && has_next) S.a_ready(nxt);
            if constexpr (SP2) {
            PG8_LDB(B0, 0, 0); PG8_LDB(B1, 0, 1); PG8_SCHED; PG8_LDA(At, 0, 0); PG8_STAGE(PG8_SA(1, 1), a1 + hstep, voffA);
            PG8_WAIT_V(8); PG8_WAIT_L(0); PG8_BAR; PG8_MMA(0, 0, At, B0); PG8_MMA(0, 1, At, B1); PG8_BAR; PG8_SCHED;
            PG8_LDA(At, 0, 1); PG8_STAGE(PG8_SB(0, 0), b2, voffB); PG8_STAGE(PG8_SB(0, 1), b2 + hstep, voffB); PG8_STAGE(PG8_SA(0, 0), a2, voffA);
            PG8_WAIT_V(8); PG8_WAIT_L(0); PG8_BAR; PG8_MMA(1, 0, At, B0); PG8_MMA(1, 1, At, B1); PG8_BAR; PG8_SCHED;
            PG8_LDB(B0, 1, 0); PG8_LDB(B1, 1, 1); PG8_SCHED; PG8_LDA(At, 1, 0); PG8_STAGE(PG8_SA(0, 1), a2 + hstep, voffA);
            PG8_WAIT_V(8); PG8_WAIT_L(0); PG8_BAR; PG8_MMA(0, 0, At, B0); PG8_MMA(0, 1, At, B1); PG8_BAR; PG8_SCHED;
            PG8_LDA(At, 1, 1); PG8_STAGE(PG8_SB(1, 0), b3, voffB); PG8_STAGE(PG8_SB(1, 1), b3 + hstep, voffB); PG8_STAGE(PG8_SA(1, 0), a3, voffA);
            PG8_WAIT_V(8); PG8_WAIT_L(0); PG8_BAR; PG8_MMA(1, 0, At, B0); PG8_MMA(1, 1, At, B1); PG8_BAR; PG8_SCHED;
            } else {
            PG8_LDB(B0, 0, 0); PG8_SCHED; PG8_LDA(At, 0, 0); PG8_STAGE(PG8_SA(1, 1), a1 + hstep, voffA);
            PG8_WAIT_L(8); PG8_BAR; PG8_WAIT_L(0); PG8_MMA(0, 0, At, B0); PG8_BAR; PG8_SCHED;
            PG8_LDB(B1, 0, 1); PG8_STAGE(PG8_SB(0, 0), b2, voffB);
            PG8_BAR; PG8_WAIT_L(0); PG8_MMA(0, 1, At, B1); PG8_BAR;
            PG8_LDA(At, 0, 1); PG8_STAGE(PG8_SA(0, 0), a2, voffA);
            PG8_BAR; PG8_WAIT_L(0); PG8_MMA(1, 0, At, B0); PG8_BAR; PG8_SCHED;
            PG8_STAGE(PG8_SB(0, 1), b2 + hstep, voffB);
            PG8_WAIT_V(6); PG8_BAR; PG8_MMA(1, 1, At, B1); PG8_BAR;
            PG8_LDB(B0, 1, 0); PG8_SCHED; PG8_LDA(At, 1, 0); PG8_STAGE(PG8_SA(0, 1), a2 + hstep, voffA);
            PG8_WAIT_L(8); PG8_BAR; PG8_WAIT_L(0); PG8_MMA(0, 0, At, B0); PG8_BAR; PG8_SCHED;
            PG8_LDB(B1, 1, 1); PG8_STAGE(PG8_SB(1, 0), b3, voffB);
            PG8_BAR; PG8_WAIT_L(0); PG8_MMA(0, 1, At, B1); PG8_BAR;
            PG8_LDA(At, 1, 1); PG8_STAGE(PG8_SA(1, 0), a3, voffA);
            PG8_BAR; PG8_WAIT_L(0); PG8_MMA(1, 0, At, B0); PG8_BAR; PG8_SCHED;
            PG8_STAGE(PG8_SB(1, 1), b3 + hstep, voffB);
            PG8_WAIT_V(6); PG8_BAR; PG8_MMA(1, 1, At, B1); PG8_BAR;
            }
        }
        if constexpr (ALIGN_EPI) { if (wr == 0) PG8_BAR; }
        if constexpr (!Epi::AFTER_DRAIN) { E(acc, cur, wr, wc, fr, fq); S.done(cur); }
        if (!has_next) break;
#pragma unroll
        for (int a = 0; a < 2; ++a)
#pragma unroll
            for (int b = 0; b < 2; ++b)
#pragma unroll
                for (int m = 0; m < 4; ++m)
#pragma unroll
                    for (int n = 0; n < 2; ++n) acc[a][b][m][n] = (f32x4){0.f, 0.f, 0.f, 0.f};
        cur = nxt; cA = nA; cB = nB; ++ui;
        if constexpr (ALIGN_EPI) { if (wr == 1) PG8_BAR; }
    }
    PG8_WAIT_V(0);
    if constexpr (!ALIGN_EPI) { if (wr == 0) PG8_BAR; }
    PG8_BAR;
    if constexpr (Epi::AFTER_DRAIN) { E.fused(acc, cur, wr, wc, fr, fq, lds, wid, lane); S.done(cur); }
#undef PG8_SA
#undef PG8_SB
#undef PG8_STAGE
#undef PG8_LDA
#undef PG8_LDB
#undef PG8_MMA
#undef PG8_WAIT_V
#undef PG8_WAIT_L
#undef PG8_BAR
#undef PG8_SCHED
}
}
#ifndef MK_N_LAUNCHES
#define MK_N_LAUNCHES 1
#endif
constexpr int NPHASE = 14;
constexpr int BATCH = 4, SEQ = 4096, D = 1024, M = BATCH * SEQ, FF = 2816, NGU = 2 * FF, NIN = 3584, DINP = 3592, NMOD = 9 * D;
constexpr float LN_EPS = 1e-5f, ALPHA = 1.189207115002721f, LOG2E = 1.4426950408889634f;
constexpr int NTHREADS = 512, NWAVES = 8;
constexpr int LDS_BYTES = 147456;
typedef unsigned short bf16;
typedef float f32x4 __attribute__((ext_vector_type(4)));
typedef float f32x16 __attribute__((ext_vector_type(16)));
typedef short bf16x8 __attribute__((ext_vector_type(8)));
typedef short s16x4 __attribute__((ext_vector_type(4)));
typedef unsigned u32x4 __attribute__((ext_vector_type(4)));
typedef unsigned u32x2 __attribute__((ext_vector_type(2)));
#define LAS __attribute__((address_space(3)))
#define LDS_WAIT() asm volatile("s_waitcnt lgkmcnt(0)" ::: "memory")

constexpr size_t MiB = 1u << 20;
constexpr size_t WS_MOD = 4 * MiB, WS_LF = 4 * MiB + 512 * 1024, WS_NB = 5 * MiB, WS_ROT = 6 * MiB;
constexpr size_t WS_WIN = 8 * MiB, WS_WWO = 15 * MiB, WS_WGU2 = 17 * MiB, WS_WD2 = 28 * MiB, WS_WGU1 = 34 * MiB, WS_WD1 = 45 * MiB;
constexpr size_t WS_ST = 34 * MiB;
constexpr size_t WS_H = 51 * MiB, WS_KV = 51 * MiB;
constexpr size_t WS_ACT = 83 * MiB;
constexpr size_t WS_FQ = 83 * MiB, WS_FK = 99 * MiB, WS_FVT = 115 * MiB, WS_RQ = 131 * MiB, WS_RK = 147 * MiB, WS_RKT = 163 * MiB, WS_RVT = 179 * MiB, WS_RG = 195 * MiB, WS_MIX = 211 * MiB;
constexpr size_t WS_END = 243 * MiB;
static_assert(WS_ACT + (size_t)M * FF * 2 <= WS_END && WS_WD1 + (size_t)D * FF * 2 <= WS_H && WS_WGU1 + (size_t)NGU * D * 2 <= WS_WD1 && WS_WD2 + (size_t)D * FF * 2 <= WS_WGU1, "ws map");

__device__ __forceinline__ unsigned f2bf(float f) { unsigned u = __builtin_bit_cast(unsigned, f); return (u + 0x7fffu + ((u >> 16) & 1u)) >> 16; }
__device__ __forceinline__ unsigned pk2(float lo, float hi) { return pg8::cvt_pk_bf16(lo, hi); }
__device__ __forceinline__ float bf2f(unsigned h) { return __builtin_bit_cast(float, h << 16); }
__device__ __forceinline__ float wave_sum(float v) {
#pragma unroll
    for (int o = 1; o < 64; o <<= 1) v += __shfl_xor(v, o);
    return v;
}
__device__ __forceinline__ float sel4(float a, float b, float c, float d, int i) { return i == 0 ? a : i == 1 ? b : i == 2 ? c : d; }

__device__ __forceinline__ void transpose_item(const float* W, int ldw, int col0, int k0, bf16* WT, int K, int drow0, int dstride, float* scr, int lane) {
#pragma unroll 8
    for (int i = 0; i < 32; ++i) { const int kk = 2 * i + (lane >> 5); scr[kk * 33 + (lane & 31)] = W[(size_t)(k0 + kk) * ldw + col0 + (lane & 31)]; }
    LDS_WAIT();
    const int c = lane & 7;
#pragma unroll
    for (int j = 0; j < 4; ++j) { const int n = (lane >> 3) + 8 * j; const float* s = scr + (8 * c) * 33 + n;
        u32x4 o; o.x = pk2(s[0 * 33], s[1 * 33]); o.y = pk2(s[2 * 33], s[3 * 33]); o.z = pk2(s[4 * 33], s[5 * 33]); o.w = pk2(s[6 * 33], s[7 * 33]);
        *(u32x4*)(WT + (size_t)(drow0 + dstride * n) * K + k0 + 8 * c) = o; }
    LDS_WAIT();
}
__device__ __forceinline__ void gu_item(const float* Wg, const float* Wu, bf16* WT, int r, float* scr, int lane) {
    const int up = r >= 1408; if (up) r -= 1408;
    const int kb = r / 88, g = r % 88, n0 = 32 * g;
    transpose_item(up ? Wu : Wg, FF, n0, 64 * kb, WT, D, 256 * (n0 >> 7) + (n0 & 127) + (up ? 128 : 0), 1, scr, lane);
}
__device__ __forceinline__ void down_item(const float* Wd, bf16* WT, int r, float* scr, int lane) {
    const int kb = r >> 5, g = r & 31;
    transpose_item(Wd, D, 32 * g, 64 * kb, WT, FF, 32 * g, 1, scr, lane);
}
__device__ __forceinline__ void win_item(const float* Win, bf16* WT, int r, float* scr, int lane) {
    const int kb = r / 112, g = r % 112; int src, dst, stride = 1;
    if (g < 48) { src = 32 * g; dst = 32 * g; }
    else if (g < 80) { const int isk = g >= 64, gg = (g - 48) & 15, head = gg >> 2, half = (gg >> 1) & 1, d0 = 32 * (gg & 1);
        src = (isk ? 2056 : 1544) + head * 128 + half * 64 + d0; dst = (isk ? 2048 : 1536) + head * 128 + 2 * d0 + half; stride = 2; }
    else { src = 8 + 32 * g; dst = 32 * g; }
    transpose_item(Win, DINP, src, 64 * kb, WT, D, dst, stride, scr, lane);
}
__device__ __forceinline__ void mod_item(const float* c, const float* w_ada, const float* b_ada, float* MOD, int it, float* red, int tid, int lane, int wid) {
    float ca[4][2];
#pragma unroll
    for (int b = 0; b < 4; ++b)
#pragma unroll
        for (int hh = 0; hh < 2; ++hh) { const float cv = c[b * D + 128 * wid + 64 * hh + lane]; ca[b][hh] = cv / (1.0f + expf(-cv)); }
    float acc[4] = {0.f, 0.f, 0.f, 0.f};
    const float* wp = w_ada + (size_t)(128 * wid) * NMOD + 64 * it + lane;
#pragma unroll
    for (int hh = 0; hh < 2; ++hh) {
#pragma unroll 16
        for (int kk = 0; kk < 64; ++kk) { const float wv = wp[(size_t)(64 * hh + kk) * NMOD];
#pragma unroll
            for (int b = 0; b < 4; ++b) acc[b] += wv * __builtin_bit_cast(float, __builtin_amdgcn_readlane(__builtin_bit_cast(int, ca[b][hh]), kk)); }
    }
#pragma unroll
    for (int b = 0; b < 4; ++b) red[(wid * 4 + b) * 64 + lane] = acc[b];
    __syncthreads();
    if (tid < 256) { const int b = tid >> 6, l = tid & 63; float s = 0.f;
#pragma unroll
        for (int w = 0; w < 8; ++w) s += red[(w * 4 + b) * 64 + l];
        MOD[b * NMOD + 64 * it + l] = s + b_ada[64 * it + l]; }
    __syncthreads();
}
__device__ __forceinline__ void rot_entry(float* ROT, int i) {
    const int s = i >> 6, d = i & 63;
    const float invf = (float)exp2((double)d * -0.20762050593046014);
    const float ang = (float)s * invf;
    const double a = (double)ang, n = rint(a * 0.6366197723675814);
    double r = fma(-n, 1.5707963267948966, a); r = fma(-n, 6.123233995736766e-17, r);
    const double r2 = r * r;
    const double sn = r * (1.0 + r2 * (-1.0 / 6 + r2 * (1.0 / 120 + r2 * (-1.0 / 5040 + r2 * (1.0 / 362880 + r2 * (-1.0 / 39916800 + r2 * (1.0 / 6227020800.0)))))));
    const double cs = 1.0 + r2 * (-0.5 + r2 * (1.0 / 24 + r2 * (-1.0 / 720 + r2 * (1.0 / 40320 + r2 * (-1.0 / 3628800 + r2 * (1.0 / 479001600.0 + r2 * (-1.0 / 87178291200.0)))))));
    const int q = ((int)n) & 3;
    const double C = (q == 0) ? cs : (q == 1) ? -sn : (q == 2) ? -cs : sn;
    const double S = (q == 0) ? sn : (q == 1) ? cs : (q == 2) ? -sn : -cs;
    ROT[2 * i] = (float)C; ROT[2 * i + 1] = (float)S;
}

__device__ __forceinline__ void modulate_pass(const float* x, const float* MOD, bf16* H, int gw, int NGW, int lane) {
    for (int m = gw; m < M; m += NGW) {
        const float* mod = MOD + (size_t)(m >> 12) * NMOD;
#pragma unroll
        for (int j = 0; j < 4; ++j) { const int col = 4 * lane + 256 * j;
            const f32x4 xv = *(const f32x4*)(x + (size_t)m * D + col), sh = *(const f32x4*)(mod + col), sc = *(const f32x4*)(mod + D + col);
            const f32x4 h = xv * (sc + 1.0f) + sh;
            u32x2 w; w.x = pk2(h[0], h[1]); w.y = pk2(h[2], h[3]); *(u32x2*)(H + (size_t)m * D + col) = w; }
    }
}
template <bool HAS_H, bool HAS_LF>
__device__ __forceinline__ void ln_pass(float* X, const float* g, const float* bt, const float* MOD, int moff, bf16* H, const float* WFs, const float* fox_b, float* LF, int gw, int NGW, int lane) {
    f32x4 gv[4], bv[4];
#pragma unroll
    for (int j = 0; j < 4; ++j) { gv[j] = *(const f32x4*)(g + 4 * lane + 256 * j); bv[j] = *(const f32x4*)(bt + 4 * lane + 256 * j); }
    for (int m = gw; m < M; m += NGW) {
        float* xr = X + (size_t)m * D;
        f32x4 v[4]; float s = 0.f;
#pragma unroll
        for (int j = 0; j < 4; ++j) { v[j] = *(const f32x4*)(xr + 4 * lane + 256 * j); s += (v[j][0] + v[j][1]) + (v[j][2] + v[j][3]); }
        const float mean = wave_sum(s) * (1.f / D); float s2 = 0.f;
#pragma unroll
        for (int j = 0; j < 4; ++j) { v[j] = v[j] - mean; s2 += (v[j][0] * v[j][0] + v[j][1] * v[j][1]) + (v[j][2] * v[j][2] + v[j][3] * v[j][3]); }
        const float rstd = 1.f / sqrtf(wave_sum(s2) * (1.f / D) + LN_EPS);
#pragma unroll
        for (int j = 0; j < 4; ++j) { v[j] = v[j] * rstd * gv[j] + bv[j]; *(f32x4*)(xr + 4 * lane + 256 * j) = v[j]; }
        if (HAS_H) {
            const float* mod = MOD + (size_t)(m >> 12) * NMOD + moff;
#pragma unroll
            for (int j = 0; j < 4; ++j) { const int col = 4 * lane + 256 * j;
                const f32x4 sh = *(const f32x4*)(mod + col), sc = *(const f32x4*)(mod + D + col);
                v[j] = v[j] * (sc + 1.0f) + sh;
                u32x2 w; w.x = pk2(v[j][0], v[j][1]); w.y = pk2(v[j][2], v[j][3]); *(u32x2*)(H + (size_t)m * D + col) = w; }
            if (HAS_LF) {
                float mine = 0.f;
#pragma unroll
                for (int hd = 0; hd < 8; ++hd) { float p = 0.f;
#pragma unroll
                    for (int j = 0; j < 4; ++j) { const f32x4 w = *(const f32x4*)(WFs + hd * D + 4 * lane + 256 * j); p += (v[j][0] * w[0] + v[j][1] * w[1]) + (v[j][2] * w[2] + v[j][3] * w[3]); }
                    p = wave_sum(p); if (lane == hd) mine = p; }
                if (lane < 8) { const float z = mine + fox_b[lane];
                    const float ls = fminf(z, 0.f) - log1pf(expf(-fabsf(z)));
                    LF[((size_t)(m >> 12) * 8 + lane) * SEQ + (m & 4095)] = ls; }
            }
        }
    }
}
__device__ __forceinline__ void cumsum_seq(const float* LF, float* NB, int sq, float* red, int tid, int lane, int wid) {
    const float* p = LF + (size_t)sq * SEQ + 8 * tid;
    const f32x4 a = *(const f32x4*)p, b = *(const f32x4*)(p + 4);
    float e[8]; e[0] = a[0]; e[1] = e[0] + a[1]; e[2] = e[1] + a[2]; e[3] = e[2] + a[3]; e[4] = e[3] + b[0]; e[5] = e[4] + b[1]; e[6] = e[5] + b[2]; e[7] = e[6] + b[3];
    float inc = e[7];
#pragma unroll
    for (int o = 1; o < 64; o <<= 1) { const float t = __shfl_up(inc, o); if (lane >= o) inc += t; }
    if (lane == 63) red[wid] = inc;
    __syncthreads();
    float off = inc - e[7];
    for (int w = 0; w < wid; ++w) off += red[w];
    f32x4 o0, o1;
    o0[0] = -(off + e[0]) * LOG2E; o0[1] = -(off + e[1]) * LOG2E; o0[2] = -(off + e[2]) * LOG2E; o0[3] = -(off + e[3]) * LOG2E;
    o1[0] = -(off + e[4]) * LOG2E; o1[1] = -(off + e[5]) * LOG2E; o1[2] = -(off + e[6]) * LOG2E; o1[3] = -(off + e[7]) * LOG2E;
    float* q = NB + (size_t)sq * SEQ + 8 * tid; *(f32x4*)q = o0; *(f32x4*)(q + 4) = o1;
    __syncthreads();
}

#define MFMA16(a, b, c) __builtin_amdgcn_mfma_f32_16x16x32_bf16((a), (b), (c), 0, 0, 0)
#define MFMA32(a, b, c) __builtin_amdgcn_mfma_f32_32x32x16_bf16((a), (b), (c), 0, 0, 0)
__device__ __forceinline__ void ret_kv_unit(const bf16* RVT, const bf16* RKT, float* KV, int bh, int j, int lane, int wid) {
    const int fr = lane & 15, fq = lane >> 4;
    bf16x8 af[4];
#pragma unroll
    for (int ks = 0; ks < 4; ++ks) af[ks] = *(const bf16x8*)(RVT + ((size_t)bh * 128 + 16 * wid + fr) * SEQ + 128 * j + 32 * ks + 8 * fq);
    float* out = KV + ((size_t)bh * 32 + j) * 16384 + (16 * wid + fr) * 128 + 4 * fq;
#pragma unroll
    for (int nb = 0; nb < 8; ++nb) { f32x4 acc = {0.f, 0.f, 0.f, 0.f};
#pragma unroll
        for (int ks = 0; ks < 4; ++ks) { const bf16x8 bfv = *(const bf16x8*)(RKT + ((size_t)bh * 128 + 16 * nb + fr) * SEQ + 128 * j + 32 * ks + 8 * fq); acc = MFMA16(bfv, af[ks], acc); }
        *(f32x4*)(out + 16 * nb) = acc; }
}
__device__ __forceinline__ void ret_scan(const float* KV, bf16* ST, int gtid, int NT, float l0, float l1, float l2, float l3) {
    for (int i = gtid; i < 16 * 4096; i += NT) {
        const int bh = i >> 12, e4 = (i & 4095) * 4;
        const float cd = __builtin_amdgcn_exp2f(sel4(l0, l1, l2, l3, bh & 3) * 128.0f);
        f32x4 s = {0.f, 0.f, 0.f, 0.f};
        for (int j = 0; j < 32; ++j) { const size_t o = ((size_t)bh * 32 + j) * 16384 + e4;
            u32x2 w; w.x = pk2(s[0], s[1]); w.y = pk2(s[2], s[3]); *(u32x2*)(ST + o) = w;
            const f32x4 kv = *(const f32x4*)(KV + o); s = s * cd + kv; }
    }
}
__device__ __forceinline__ void ret_out_unit(unsigned char* lds, int bh, int ci, const bf16* RQ, const bf16* RK, const bf16* RVT, const bf16* ST, const bf16* RG,
                                             const float* gn_g, const float* gn_b, bf16* MIX, float lg2, int lane, int wid) {
    const int fr = lane & 15, fq = lane >> 4, b = bh >> 2, h = bh & 3;
    const size_t row = (size_t)b * SEQ + ci * 128 + wid * 16 + fr;
    bf16* Sp = (bf16*)lds + wid * (16 * 136);
    bf16x8 qf[4];
#pragma unroll
    for (int ks = 0; ks < 4; ++ks) qf[ks] = *(const bf16x8*)(RQ + row * 512 + h * 128 + 32 * ks + 8 * fq);
    f32x4 acc[8];
#pragma unroll
    for (int nb = 0; nb < 8; ++nb) { acc[nb] = (f32x4){0.f, 0.f, 0.f, 0.f};
#pragma unroll
        for (int ks = 0; ks < 4; ++ks) { const bf16x8 kf = *(const bf16x8*)(RK + ((size_t)b * SEQ + ci * 128 + 16 * nb + fr) * 512 + h * 128 + 32 * ks + 8 * fq); acc[nb] = MFMA16(kf, qf[ks], acc[nb]); } }
    const int rt = wid * 16 + fr;
#pragma unroll
    for (int nb = 0; nb < 8; ++nb) { const int j0 = 16 * nb + 4 * fq; float v[4];
#pragma unroll
        for (int e = 0; e < 4; ++e) { const int diff = rt - (j0 + e); v[e] = diff >= 0 ? acc[nb][e] * __builtin_amdgcn_exp2f(lg2 * (float)diff) : 0.f; }
        u32x2 w; w.x = pk2(v[0], v[1]); w.y = pk2(v[2], v[3]); *(u32x2*)(Sp + fr * 136 + j0) = w; }
    LDS_WAIT();
    bf16x8 sf[4];
#pragma unroll
    for (int ks = 0; ks < 4; ++ks) sf[ks] = *(const bf16x8*)(Sp + fr * 136 + 32 * ks + 8 * fq);
    LDS_WAIT();
    const bf16* STp = ST + ((size_t)bh * 32 + ci) * 16384;
#pragma unroll
    for (int nb = 0; nb < 8; ++nb) { acc[nb] = (f32x4){0.f, 0.f, 0.f, 0.f};
#pragma unroll
        for (int ks = 0; ks < 4; ++ks) { const bf16x8 bfv = *(const bf16x8*)(STp + (16 * nb + fr) * 128 + 32 * ks + 8 * fq); acc[nb] = MFMA16(bfv, qf[ks], acc[nb]); } }
    const float qd = __builtin_amdgcn_exp2f(lg2 * (float)(rt + 1));
#pragma unroll
    for (int nb = 0; nb < 8; ++nb) { acc[nb] = acc[nb] * qd;
#pragma unroll
        for (int ks = 0; ks < 4; ++ks) { const bf16x8 vf = *(const bf16x8*)(RVT + ((size_t)bh * 128 + 16 * nb + fr) * SEQ + ci * 128 + 32 * ks + 8 * fq); acc[nb] = MFMA16(vf, sf[ks], acc[nb]); } }
    float s = 0.f;
#pragma unroll
    for (int nb = 0; nb < 8; ++nb) s += (acc[nb][0] + acc[nb][1]) + (acc[nb][2] + acc[nb][3]);
    s += __shfl_xor(s, 16); s += __shfl_xor(s, 32);
    const float mean = s * (1.f / 128.f); float q = 0.f;
#pragma unroll
    for (int nb = 0; nb < 8; ++nb) { acc[nb] = acc[nb] - mean; q += (acc[nb][0] * acc[nb][0] + acc[nb][1] * acc[nb][1]) + (acc[nb][2] * acc[nb][2] + acc[nb][3] * acc[nb][3]); }
    q += __shfl_xor(q, 16); q += __shfl_xor(q, 32);
    const float rstd = 1.f / sqrtf(q * (1.f / 128.f) + LN_EPS);
#pragma unroll
    for (int nb = 0; nb < 8; ++nb) { const int c = h * 128 + 16 * nb + 4 * fq;
        const f32x4 g = *(const f32x4*)(gn_g + c), bb = *(const f32x4*)(gn_b + c);
        const u32x2 rg = *(const u32x2*)(RG + row * 512 + c);
        const f32x4 gate = {bf2f(rg.x & 0xffffu), bf2f(rg.x >> 16), bf2f(rg.y & 0xffffu), bf2f(rg.y >> 16)};
        const f32x4 o = (acc[nb] * rstd * g + bb) * gate;
        u32x2 w; w.x = pk2(o[0], o[1]); w.y = pk2(o[2], o[3]); *(u32x2*)(MIX + row * 1024 + 512 + c) = w; }
}

__device__ __forceinline__ int crow(int r, int hi) { return (r & 3) + 8 * (r >> 2) + 4 * hi; }
constexpr int KP = 72, VP = 68;
constexpr int FOX_K = 0, FOX_V = 2 * 64 * KP * 2, FOX_NB = FOX_V + 2 * 64 * VP * 2;
__device__ __forceinline__ void fox_unit(unsigned char* lds, int b, int h, int qb, const bf16* FQ, const bf16* FK, const bf16* FVT, const float* NBg, bf16* MIX, int tid, int lane, int wid) {
    const int r32 = lane & 31, hi = lane >> 5;
    bf16* Ks = (bf16*)(lds + FOX_K); bf16* Vs = (bf16*)(lds + FOX_V); float* nb = (float*)(lds + FOX_NB);
    const int q0 = qb * 256, NT = 4 * qb + 4;
    { const float* src = NBg + (size_t)(b * 8 + h) * SEQ;
      for (int i = tid * 4; i < q0 + 256; i += NTHREADS * 4) *(f32x4*)(nb + i) = *(const f32x4*)(src + i); }
    const size_t qrow = (size_t)b * SEQ + q0 + wid * 32 + r32;
    bf16x8 qf[4];
#pragma unroll
    for (int d0 = 0; d0 < 4; ++d0) qf[d0] = *(const bf16x8*)(FQ + qrow * 512 + h * 64 + d0 * 16 + hi * 8);
    const int skey = tid >> 3, sch = tid & 7;
    const bf16* kg = FK + ((size_t)b * SEQ + skey) * 512 + h * 64 + sch * 8;
    const bf16* vg = FVT + ((size_t)(b * 8 + h) * 64 + skey) * SEQ + sch * 8;
    u32x4 kr = *(const u32x4*)kg, vr = *(const u32x4*)vg;
    *(u32x4*)(Ks + skey * KP + sch * 8) = kr;
    { u32x2 lo = {vr.x, vr.y}, hi2 = {vr.z, vr.w}; *(u32x2*)(Vs + skey * VP + sch * 8) = lo; *(u32x2*)(Vs + skey * VP + sch * 8 + 4) = hi2; }
    __syncthreads();
    float m_run = -INFINITY, l_run = 0.f;
    f32x16 oT[2]; oT[0] = f32x16{}; oT[1] = f32x16{};
    const int my_last = 4 * qb + (wid >> 1);
    const int qg = q0 + wid * 32 + r32;
    for (int t = 0; t < NT; ++t) {
        const int cur = t & 1;
        if (t + 1 < NT) { kr = *(const u32x4*)(kg + (size_t)(t + 1) * 64 * 512); vr = *(const u32x4*)(vg + (t + 1) * 64); }
        if (t <= my_last) {
            const bf16* Kb = Ks + cur * 64 * KP; const bf16* Vb = Vs + cur * 64 * VP;
            f32x16 p0 = f32x16{}, p1 = f32x16{};
#pragma unroll
            for (int d0 = 0; d0 < 4; ++d0) {
                const bf16x8 a0 = *(const bf16x8*)(Kb + r32 * KP + d0 * 16 + hi * 8), a1 = *(const bf16x8*)(Kb + (32 + r32) * KP + d0 * 16 + hi * 8);
                p0 = MFMA32(a0, qf[d0], p0); p1 = MFMA32(a1, qf[d0], p1); }
            const int kv0 = t * 64;
#pragma unroll
            for (int g = 0; g < 4; ++g) { const f32x4 b0 = *(const f32x4*)(nb + kv0 + 8 * g + 4 * hi), b1 = *(const f32x4*)(nb + kv0 + 32 + 8 * g + 4 * hi);
#pragma unroll
                for (int e = 0; e < 4; ++e) { p0[4 * g + e] += b0[e]; p1[4 * g + e] += b1[e]; } }
            if (t >= 4 * qb) {
#pragma unroll
                for (int r = 0; r < 16; ++r) { const int kv = kv0 + crow(r, hi); if (kv > qg) p0[r] = -INFINITY; if (kv + 32 > qg) p1[r] = -INFINITY; }
            }
            float mx = fmaxf(p0[0], p1[0]);
#pragma unroll
            for (int r = 1; r < 16; ++r) mx = fmaxf(mx, fmaxf(p0[r], p1[r]));
            mx = fmaxf(mx, __shfl_xor(mx, 32));
            const float m_new = fmaxf(m_run, mx);
            const float alpha = __builtin_amdgcn_exp2f(m_run - m_new);
            m_run = m_new;
            float sum = 0.f;
#pragma unroll
            for (int r = 0; r < 16; ++r) { p0[r] = __builtin_amdgcn_exp2f(p0[r] - m_new); p1[r] = __builtin_amdgcn_exp2f(p1[r] - m_new); sum += p0[r] + p1[r]; }
            l_run = l_run * alpha + sum;
#pragma unroll
            for (int r = 0; r < 16; ++r) { oT[0][r] *= alpha; oT[1][r] *= alpha; }
            u32x4 pb[2][2];
#pragma unroll
            for (int ks = 0; ks < 2; ++ks) {
                pb[0][ks] = (u32x4){pk2(p0[8 * ks + 0], p0[8 * ks + 1]), pk2(p0[8 * ks + 2], p0[8 * ks + 3]), pk2(p0[8 * ks + 4], p0[8 * ks + 5]), pk2(p0[8 * ks + 6], p0[8 * ks + 7])};
                pb[1][ks] = (u32x4){pk2(p1[8 * ks + 0], p1[8 * ks + 1]), pk2(p1[8 * ks + 2], p1[8 * ks + 3]), pk2(p1[8 * ks + 4], p1[8 * ks + 5]), pk2(p1[8 * ks + 6], p1[8 * ks + 7])}; }
#pragma unroll
            for (int dblk = 0; dblk < 2; ++dblk)
#pragma unroll
                for (int half = 0; half < 2; ++half)
#pragma unroll
                    for (int ks = 0; ks < 2; ++ks) {
                        const bf16* va = Vb + (32 * dblk + r32) * VP + 32 * half + 16 * ks + 4 * hi;
                        const s16x4 lo = *(const s16x4*)va, hi4 = *(const s16x4*)(va + 8);
                        const bf16x8 A = {lo[0], lo[1], lo[2], lo[3], hi4[0], hi4[1], hi4[2], hi4[3]};
                        oT[dblk] = MFMA32(A, __builtin_bit_cast(bf16x8, pb[half][ks]), oT[dblk]); }
        }
        if (t + 1 < NT) {
            bf16* Kw = Ks + (cur ^ 1) * 64 * KP; bf16* Vw = Vs + (cur ^ 1) * 64 * VP;
            *(u32x4*)(Kw + skey * KP + sch * 8) = kr;
            u32x2 lo = {vr.x, vr.y}, hi2 = {vr.z, vr.w}; *(u32x2*)(Vw + skey * VP + sch * 8) = lo; *(u32x2*)(Vw + skey * VP + sch * 8 + 4) = hi2;
        }
        __syncthreads();
    }
    l_run += __shfl_xor(l_run, 32);
    const float inv = 1.0f / l_run;
    bf16* orow = MIX + qrow * 1024 + h * 64;
#pragma unroll
    for (int dblk = 0; dblk < 2; ++dblk)
#pragma unroll
        for (int g = 0; g < 4; ++g) { u32x2 w; w.x = pk2(oT[dblk][4 * g] * inv, oT[dblk][4 * g + 1] * inv); w.y = pk2(oT[dblk][4 * g + 2] * inv, oT[dblk][4 * g + 3] * inv);
            *(u32x2*)(orow + 32 * dblk + 8 * g + 4 * hi) = w; }
}

struct Args { const float* in[21]; float* out; unsigned char* ws; float lg2g[4]; int ph_lo, ph_hi; };
__global__ void __launch_bounds__(NTHREADS, 2) fwd_megakernel(Args args) {
    extern __shared__ __attribute__((aligned(16))) unsigned char lds[];
    cg::grid_group grid = cg::this_grid();
    const int tid = threadIdx.x, lane = tid & 63, wid = __builtin_amdgcn_readfirstlane(tid >> 6);
    const int G = gridDim.x, blk = blockIdx.x;
    const int gw = blk * NWAVES + wid, NGW = G * NWAVES, gtid = blk * NTHREADS + tid, NT = G * NTHREADS;
    unsigned char* ws = args.ws;
    const float* x = args.in[0];
    float* OUT = args.out;
    float* MOD = (float*)(ws + WS_MOD); float* LF = (float*)(ws + WS_LF); float* NB = (float*)(ws + WS_NB); float* ROT = (float*)(ws + WS_ROT);
    bf16* W_IN = (bf16*)(ws + WS_WIN); bf16* W_WO = (bf16*)(ws + WS_WWO); bf16* W_GU2 = (bf16*)(ws + WS_WGU2); bf16* W_D2 = (bf16*)(ws + WS_WD2);
    bf16* W_GU1 = (bf16*)(ws + WS_WGU1); bf16* W_D1 = (bf16*)(ws + WS_WD1); bf16* ST = (bf16*)(ws + WS_ST);
    bf16* H = (bf16*)(ws + WS_H); float* KV = (float*)(ws + WS_KV); bf16* ACT = (bf16*)(ws + WS_ACT);
    bf16* FQ = (bf16*)(ws + WS_FQ); bf16* FK = (bf16*)(ws + WS_FK); bf16* FVT = (bf16*)(ws + WS_FVT); bf16* RQ = (bf16*)(ws + WS_RQ); bf16* RK = (bf16*)(ws + WS_RK);
    bf16* RKT = (bf16*)(ws + WS_RKT); bf16* RVT = (bf16*)(ws + WS_RVT); bf16* RG = (bf16*)(ws + WS_RG); bf16* MIX = (bf16*)(ws + WS_MIX);
    const float l0 = args.lg2g[0], l1 = args.lg2g[1], l2 = args.lg2g[2], l3 = args.lg2g[3];
    const int lo = args.ph_lo, hi = args.ph_hi;
#define IN(k) (lo <= (k) && (k) < hi)
#define SEAM(k) do { if (IN(k) && IN((k) + 1)) grid.sync(); } while (0)
    PG8_LAS unsigned char* ldsp = (PG8_LAS unsigned char*)lds;

    if (IN(0)) {
        for (int it = blk; it < NMOD / 64; it += G) mod_item(args.in[1], args.in[2], args.in[3], MOD, it, (float*)lds, tid, lane, wid);
        for (int i = gtid; i < SEQ * 64; i += NT) rot_entry(ROT, i);
        float* scr = (float*)(lds + 16384 + wid * 16384);
        constexpr int I_GU = 2816, I_D = 1408, I_IN = 1792, I_WO = 512, NITEMS = 2 * I_GU + 2 * I_D + I_IN + I_WO;
        for (int it = gw; it < NITEMS; it += NGW) {
            int r = it;
            if (r < I_GU) { gu_item(args.in[4], args.in[5], W_GU1, r, scr, lane); continue; } r -= I_GU;
            if (r < I_D) { down_item(args.in[6], W_D1, r, scr, lane); continue; } r -= I_D;
            if (r < I_IN) { win_item(args.in[9], W_IN, r, scr, lane); continue; } r -= I_IN;
            if (r < I_WO) { transpose_item(args.in[13], D, 32 * (r & 31), 64 * (r >> 5), W_WO, D, 32 * (r & 31), 1, scr, lane); continue; } r -= I_WO;
            if (r < I_GU) { gu_item(args.in[16], args.in[17], W_GU2, r, scr, lane); continue; } r -= I_GU;
            down_item(args.in[18], W_D2, r, scr, lane);
        }
    }
    SEAM(0);
    if (IN(1)) modulate_pass(x, MOD, H, gw, NGW, lane);
    SEAM(1);
    if (IN(2)) { pg8::Gemm g{H, W_GU1, M, NGU, D}; pg8::StaticOrder S; S.init(M, NGU, G, blk); pg8::EpiSwiglu E{ACT, FF};
        pg8::gemm_phase<pg8::EpiSwiglu, pg8::StaticOrder, true, true>(ldsp, g, S, E); }
    SEAM(2);
    if (IN(3)) { pg8::Gemm g{ACT, W_D1, M, D, FF}; pg8::StaticOrder S; S.init(M, D, G, blk); pg8::EpiResid E{x, OUT, MOD + 2 * D, ALPHA, 0.5f, SEQ, NMOD};
        pg8::gemm_phase<pg8::EpiResid, pg8::StaticOrder, true, true>(ldsp, g, S, E); }
    SEAM(3);
    if (IN(4)) {
        float* WFs = (float*)lds;
        for (int i = tid; i < 8 * D; i += NTHREADS) { const int k = i >> 3, hd = i & 7; WFs[hd * D + k] = args.in[9][(size_t)k * DINP + 1536 + hd]; }
        __syncthreads();
        ln_pass<true, true>(OUT, args.in[7], args.in[8], MOD, 3 * D, H, WFs, args.in[10], LF, gw, NGW, lane);
        __syncthreads();
    }
    SEAM(4);
    if (IN(5)) {
        for (int sq = blk; sq < BATCH * 8; sq += G) cumsum_seq(LF, NB, sq, (float*)lds, tid, lane, wid);
        pg8::Gemm g{H, W_IN, M, NIN, D}; pg8::StaticOrder S; S.init(M, NIN, G, blk);
        pg8::EpiInProj E{FQ, FK, FVT, RQ, RK, RKT, RVT, RG, ROT, l0, l1, l2, l3};
        pg8::gemm_phase<pg8::EpiInProj, pg8::StaticOrder, true, true>(ldsp, g, S, E);
    }
    SEAM(5);
    if (IN(6)) { for (int u = blk; u < 512; u += G) ret_kv_unit(RVT, RKT, KV, u >> 5, u & 31, lane, wid); }
    SEAM(6);
    if (IN(7)) {
        ret_scan(KV, ST, gtid, NT, l0, l1, l2, l3);
        for (int it = blk; it < 512; it += G) { const int i2 = it & 255, bh = i2 >> 3, s = i2 & 7, qb = (it < 256) ? 15 - s : s;
            fox_unit(lds, bh >> 3, bh & 7, qb, FQ, FK, FVT, NB, MIX, tid, lane, wid); }
    }
    SEAM(7);
    if (IN(8)) { for (int u = blk; u < 512; u += G) { const int bh = u >> 5; ret_out_unit(lds, bh, u & 31, RQ, RK, RVT, ST, RG, args.in[11], args.in[12], MIX, sel4(l0, l1, l2, l3, bh & 3), lane, wid); } }
    SEAM(8);
    if (IN(9)) { pg8::Gemm g{MIX, W_WO, M, D, D}; pg8::StaticOrder S; S.init(M, D, G, blk); pg8::EpiResid E{OUT, OUT, MOD + 5 * D, ALPHA, 1.0f, SEQ, NMOD};
        pg8::gemm_phase<pg8::EpiResid, pg8::StaticOrder, true, true>(ldsp, g, S, E); }
    SEAM(9);
    if (IN(10)) ln_pass<true, false>(OUT, args.in[14], args.in[15], MOD, 6 * D, H, nullptr, nullptr, nullptr, gw, NGW, lane);
    SEAM(10);
    if (IN(11)) { pg8::Gemm g{H, W_GU2, M, NGU, D}; pg8::StaticOrder S; S.init(M, NGU, G, blk); pg8::EpiSwiglu E{ACT, FF};
        pg8::gemm_phase<pg8::EpiSwiglu, pg8::StaticOrder, true, true>(ldsp, g, S, E); }
    SEAM(11);
    if (IN(12)) { pg8::Gemm g{ACT, W_D2, M, D, FF}; pg8::StaticOrder S; S.init(M, D, G, blk); pg8::EpiResid E{OUT, OUT, MOD + 8 * D, ALPHA, 0.5f, SEQ, NMOD};
        pg8::gemm_phase<pg8::EpiResid, pg8::StaticOrder, true, true>(ldsp, g, S, E); }
    SEAM(12);
    if (IN(13)) ln_pass<false, false>(OUT, args.in[19], args.in[20], nullptr, 0, nullptr, nullptr, nullptr, nullptr, gw, NGW, lane);
#undef IN
#undef SEAM
}

extern "C" void kernel_launch(void* const* d_in, const int* in_sizes, int n_in, void* d_out, int out_size, void* d_ws, size_t ws_size, hipStream_t stream) {
    static int grid = 0;
    if (grid == 0) {
        if (n_in != 21 || out_size != M * D || ws_size < WS_END) { fprintf(stderr, "kernel_launch: unexpected problem geometry (n_in %d, out %d, ws %zu)\n", n_in, out_size, ws_size); grid = -1; return; }
        int dev = 0, cus = 0, per_cu = 0;
        hipGetDevice(&dev); hipDeviceGetAttribute(&cus, hipDeviceAttributeMultiprocessorCount, dev);
        if (hipFuncSetAttribute((const void*)fwd_megakernel, hipFuncAttributeMaxDynamicSharedMemorySize, LDS_BYTES) != hipSuccess) { fprintf(stderr, "kernel_launch: hipFuncSetAttribute failed\n"); grid = -1; return; }
        if (hipOccupancyMaxActiveBlocksPerMultiprocessor(&per_cu, (const void*)fwd_megakernel, NTHREADS, LDS_BYTES) != hipSuccess || per_cu < 1) { fprintf(stderr, "kernel_launch: occupancy query says %d\n", per_cu); per_cu = 1; }
        (void)hipGetLastError();
        grid = cus * per_cu;
    }
    if (grid < 0) return;
    Args a{};
    for (int i = 0; i < 21; ++i) a.in[i] = (const float*)d_in[i];
    a.out = (float*)d_out; a.ws = (unsigned char*)d_ws;
    for (int h = 0; h < 4; ++h) a.lg2g[h] = (float)std::log2(1.0 - std::pow(2.0, -5.0 - h));
#if MK_N_LAUNCHES == 1
    a.ph_lo = 0; a.ph_hi = NPHASE;
    void* kargs[] = {&a};
    hipError_t e = hipLaunchCooperativeKernel((const void*)fwd_megakernel, dim3(grid), dim3(NTHREADS), kargs, LDS_BYTES, stream);
    if (e != hipSuccess) fprintf(stderr, "kernel_launch: cooperative launch failed: %s (grid %d)\n", hipGetErrorString(e), grid);
#else
    for (int p = 0; p < NPHASE; ++p) { a.ph_lo = p; a.ph_hi = p + 1; hipLaunchKernelGGL(fwd_megakernel, dim3(grid), dim3(NTHREADS), LDS_BYTES, stream, a); }
#endif
}
```

```cpp
#include <hip/hip_runtime.h>
#include <hip/hip_cooperative_groups.h>
#include <cstdio>
#include <cstdint>
#include <cmath>
namespace cg = cooperative_groups;
namespace pg8 {
#define PG8_LAS __attribute__((address_space(3)))
typedef unsigned short bf16_t;
typedef short bf16x8 __attribute__((ext_vector_type(8)));
typedef float f32x4 __attribute__((ext_vector_type(4)));
typedef unsigned u32x4 __attribute__((ext_vector_type(4)));
constexpr int BM = 256, BK = 64, HALF = 128, HTB = HALF * BK * 2  , STAGE_BYTES = 8 * HTB, NXCD = 8, WGM = 8;

__host__ __device__ __forceinline__ int lds_byte(int r, int c) { const int st = (r >> 4) * 2 + (c >> 5), rr = r & 15, cc = c & 31, ob = rr * 64 + cc * 2; return st * 1024 + (ob ^ (((ob >> 9) & 1) << 5)); }
__host__ __device__ __forceinline__ void stage_rc(int b, int& R, int& C) { const int st = b / 1024, sb = b % 1024, swz = sb ^ (((sb >> 9) & 1) << 5); R = (st >> 1) * 16 + swz / 64; C = (st & 1) * 32 + (swz % 64) / 2; }
__host__ __device__ __forceinline__ int perm32(int rho) { const int n = rho >> 4, i = rho & 15; return 8 * (i >> 2) + 4 * n + (i & 3); }

struct Unit { int pm, pn; };
struct Gemm { const bf16_t* A; const bf16_t* Bt; int M, N, K; };

struct StaticOrder {
    int nM, nN, nwg, G, c;
    __host__ __device__ void init(int M, int N, int G_, int c_) { nM = M / BM; nN = N / BM; nwg = nM * nN; G = G_; c = c_; }
    __host__ __device__ bool next(int i, Unit& u) const {
        const long L = (long)i * G + c; if (L >= nwg) return false;
        int wgid = (int)L; { const int q = nwg / NXCD, r = nwg % NXCD, xcd = wgid % NXCD, off = wgid / NXCD; wgid = (xcd < r ? xcd * (q + 1) : r * (q + 1) + (xcd - r) * q) + off; }
        const int nig = WGM * nN, gid = wgid / nig, fm = gid * WGM, gsz = (nM - fm) < WGM ? (nM - fm) : WGM;
        u.pm = fm + ((wgid % nig) % gsz); u.pn = (wgid % nig) / gsz; return true;
    }
    __device__ __forceinline__ void a_ready(const Unit&) const {}
    __device__ __forceinline__ void done(const Unit&) const {}
};

__device__ __forceinline__ unsigned cvt_pk_bf16(float lo, float hi) { unsigned r; asm volatile("v_cvt_pk_bf16_f32 %0, %1, %2" : "=v"(r) : "v"(lo), "v"(hi)); return r; }
typedef float f32x2 __attribute__((ext_vector_type(2)));
typedef unsigned u32x2 __attribute__((ext_vector_type(2)));
__device__ __forceinline__ float silu_f(float g) { return g * __builtin_amdgcn_rcpf(1.0f + __builtin_amdgcn_exp2f(-1.4426950408889634f * g)); }

struct EpiSwiglu {
    static constexpr bool PERM = true, AFTER_DRAIN = false;
    bf16_t* O; int ldc;
    __device__ __forceinline__ void operator()(const f32x4 (&acc)[2][2][4][2], const Unit& u, int wr, int wc, int fr, int fq) const {
        const int row0 = u.pm * BM + wr * 64 + fr, col0 = u.pn * HALF + wc * 32 + 8 * fq;
#pragma unroll
        for (int ai = 0; ai < 2; ++ai)
#pragma unroll
            for (int m = 0; m < 4; ++m) {
                bf16_t* rowp = O + (size_t)(row0 + ai * HALF + m * 16) * ldc + col0;
                const f32x4 g0 = acc[ai][0][m][0], g1 = acc[ai][0][m][1], u0 = acc[ai][1][m][0], u1 = acc[ai][1][m][1];
                u32x4 w;
                w.x = cvt_pk_bf16(silu_f(g0[0]) * u0[0], silu_f(g0[1]) * u0[1]); w.y = cvt_pk_bf16(silu_f(g0[2]) * u0[2], silu_f(g0[3]) * u0[3]);
                w.z = cvt_pk_bf16(silu_f(g1[0]) * u1[0], silu_f(g1[1]) * u1[1]); w.w = cvt_pk_bf16(silu_f(g1[2]) * u1[2], silu_f(g1[3]) * u1[3]);
                *(u32x4*)rowp = w;
            }
    }
};

struct EpiResid {
    static constexpr bool PERM = false, AFTER_DRAIN = false;
    const float* xin; float* out; const float* gmod; float alpha, coef; int seq, modstride;
    __device__ __forceinline__ void operator()(const f32x4 (&acc)[2][2][4][2], const Unit& u, int wr, int wc, int fr, int fq) const {
        const int row0 = u.pm * BM + wr * 64 + fr, col0 = u.pn * BM + wc * 32 + 4 * fq;
        const float* gp = gmod + (size_t)((u.pm * BM) / seq) * modstride;
#pragma unroll
        for (int bj = 0; bj < 2; ++bj)
#pragma unroll
            for (int n = 0; n < 2; ++n) {
                const f32x4 gv = *(const f32x4*)(gp + col0 + bj * HALF + n * 16) * coef;
#pragma unroll
                for (int ai = 0; ai < 2; ++ai)
#pragma unroll
                    for (int m = 0; m < 4; ++m) {
                        const size_t off = (size_t)(row0 + ai * HALF + m * 16) * 1024 + col0 + bj * HALF + n * 16;
                        const f32x4 xv = *(const f32x4*)(xin + off);
                        *(f32x4*)(out + off) = xv * alpha + gv * acc[ai][bj][m][n];
                    }
            }
    }
};

struct EpiInProj {
    static constexpr bool PERM = true, AFTER_DRAIN = false;
    bf16_t *FQ, *FK, *FVT, *RQ, *RK, *RKT, *RVT, *RG; const float* ROT; float lg0, lg1, lg2v, lg3;
    __device__ __forceinline__ void operator()(const f32x4 (&acc)[2][2][4][2], const Unit& u, int wr, int wc, int fr, int fq) const {
        const int t = u.pn >> 1, sub = u.pn & 1;
        const int row0 = u.pm * BM + wr * 64 + fr;
        const int b = (u.pm * BM) >> 12, s0 = (u.pm * BM) & 4095;
        if (t == 0 || t == 1 || t == 6) {
            bf16_t* base = (t == 0) ? FQ : (t == 1) ? FK : RG;
            const float sc = (t == 0) ? 0.125f * 1.4426950408889634f : 1.0f;
            const int col0 = sub * BM + wc * 32 + 8 * fq;
#pragma unroll
            for (int ai = 0; ai < 2; ++ai)
#pragma unroll
                for (int m = 0; m < 4; ++m) { bf16_t* rowp = base + (size_t)(row0 + ai * HALF + m * 16) * 512 + col0;
#pragma unroll
                    for (int bj = 0; bj < 2; ++bj) { f32x4 v0 = acc[ai][bj][m][0], v1 = acc[ai][bj][m][1];
                        if (t == 6) { v0 = (f32x4){silu_f(v0[0]), silu_f(v0[1]), silu_f(v0[2]), silu_f(v0[3])}; v1 = (f32x4){silu_f(v1[0]), silu_f(v1[1]), silu_f(v1[2]), silu_f(v1[3])}; }
                        else { v0 = v0 * sc; v1 = v1 * sc; }
                        u32x4 w; w.x = cvt_pk_bf16(v0[0], v0[1]); w.y = cvt_pk_bf16(v0[2], v0[3]); w.z = cvt_pk_bf16(v1[0], v1[1]); w.w = cvt_pk_bf16(v1[2], v1[3]);
                        *(u32x4*)(rowp + bj * HALF) = w; } }
        } else if (t == 2 || t == 5) {
            bf16_t* base = (t == 2) ? FVT : RVT;
#pragma unroll
            for (int bj = 0; bj < 2; ++bj) {
                const int c0 = sub * BM + bj * HALF + wc * 32 + 8 * fq;
                bf16_t* cp = base + ((size_t)b * 512 + c0) * 4096 + s0 + wr * 64 + fr;
#pragma unroll
                for (int ai = 0; ai < 2; ++ai)
#pragma unroll
                    for (int m = 0; m < 4; ++m) { bf16_t* p = cp + ai * HALF + m * 16;
#pragma unroll
                        for (int n = 0; n < 2; ++n) { const f32x4 v = acc[ai][bj][m][n];
                            const unsigned w0 = cvt_pk_bf16(v[0], v[1]), w1 = cvt_pk_bf16(v[2], v[3]);
                            p[(size_t)(4 * n + 0) * 4096] = (bf16_t)(w0 & 0xffffu); p[(size_t)(4 * n + 1) * 4096] = (bf16_t)(w0 >> 16);
                            p[(size_t)(4 * n + 2) * 4096] = (bf16_t)(w1 & 0xffffu); p[(size_t)(4 * n + 3) * 4096] = (bf16_t)(w1 >> 16); } }
            }
        } else {
            const bool isk = (t == 4);
            const float sc = isk ? 0.08838834764831845f : 1.0f;
            bf16_t* base = isk ? RK : RQ;
            const int d0 = 16 * wc + 4 * fq;
#pragma unroll
            for (int bj = 0; bj < 2; ++bj) {
                const int hh = 2 * sub + bj;
                const float lg2 = (hh == 0) ? lg0 : (hh == 1) ? lg1 : (hh == 2) ? lg2v : lg3;
#pragma unroll
                for (int ai = 0; ai < 2; ++ai)
#pragma unroll
                    for (int m = 0; m < 4; ++m) {
                        const int sl = wr * 64 + ai * HALF + m * 16 + fr, s = s0 + sl;
                        const f32x4 r0 = *(const f32x4*)(ROT + ((size_t)s * 64 + d0) * 2), r1 = *(const f32x4*)(ROT + ((size_t)s * 64 + d0) * 2 + 4);
                        const f32x4 v0 = acc[ai][bj][m][0] * sc, v1 = acc[ai][bj][m][1] * sc;
                        float a[4], c[4];
                        a[0] = v0[0] * r0[0] - v0[1] * r0[1]; c[0] = v0[0] * r0[1] + v0[1] * r0[0];
                        a[1] = v0[2] * r0[2] - v0[3] * r0[3]; c[1] = v0[2] * r0[3] + v0[3] * r0[2];
                        a[2] = v1[0] * r1[0] - v1[1] * r1[1]; c[2] = v1[0] * r1[1] + v1[1] * r1[0];
                        a[3] = v1[2] * r1[2] - v1[3] * r1[3]; c[3] = v1[2] * r1[3] + v1[3] * r1[2];
                        bf16_t* rowp = base + (size_t)(u.pm * BM + sl) * 512 + hh * 128 + d0;
                        u32x2 w; w.x = cvt_pk_bf16(a[0], a[1]); w.y = cvt_pk_bf16(a[2], a[3]); *(u32x2*)rowp = w;
                        w.x = cvt_pk_bf16(c[0], c[1]); w.y = cvt_pk_bf16(c[2], c[3]); *(u32x2*)(rowp + 64) = w;
                        if (isk) {
                            const float dec = __builtin_amdgcn_exp2f(lg2 * (float)(127 - (s & 127)));
                            bf16_t* p = RKT + ((size_t)(b * 4 + hh) * 128 + d0) * 4096 + s;
                            const unsigned x0 = cvt_pk_bf16(a[0] * dec, a[1] * dec), x1 = cvt_pk_bf16(a[2] * dec, a[3] * dec);
                            const unsigned y0 = cvt_pk_bf16(c[0] * dec, c[1] * dec), y1 = cvt_pk_bf16(c[2] * dec, c[3] * dec);
                            p[0] = (bf16_t)(x0 & 0xffffu); p[4096] = (bf16_t)(x0 >> 16); p[2 * 4096] = (bf16_t)(x1 & 0xffffu); p[3 * 4096] = (bf16_t)(x1 >> 16);
                            p += (size_t)64 * 4096;
                            p[0] = (bf16_t)(y0 & 0xffffu); p[4096] = (bf16_t)(y0 >> 16); p[2 * 4096] = (bf16_t)(y1 & 0xffffu); p[3 * 4096] = (bf16_t)(y1 >> 16);
                        }
                    }
            }
        }
    }
};
template <class Epi, class Sched, bool ALIGN_EPI = false, bool SP2 = false>
__device__ __forceinline__ void gemm_phase(PG8_LAS unsigned char* lds, const Gemm g, const Sched& S, const Epi& E) {
    const int tid = threadIdx.x, wid = __builtin_amdgcn_readfirstlane(tid >> 6), lane = tid & 63, wr = wid >> 2, wc = wid & 3, fr = lane & 15, fq = lane >> 4;
    const int K = g.K, nt = K / BK;
    unsigned voffA[2], voffB[2];
#pragma unroll
    for (int i = 0; i < 2; ++i) { int R, C; stage_rc(tid * 16 + i * 8192, R, C); const int Rb = Epi::PERM ? ((R & ~31) + perm32(R & 31)) : R;
        voffA[i] = (unsigned)(R * K + C) * 2u; voffB[i] = (unsigned)(Rb * K + C) * 2u; }
    const size_t kstep = (size_t)(BK * 2);
    const size_t hstep = (size_t)HALF * K * 2;
    const size_t tstep = 2 * hstep;
    const unsigned ldsw = (unsigned)wid * 1024u;
    const int aoff = lds_byte(wr * 64 + fr, fq * 8), boff = lds_byte(wc * 32 + fr, fq * 8);
#define PG8_SA(b, h) (((b) * 2 + (h)) * HTB)
#define PG8_SB(b, h) ((4 + (b) * 2 + (h)) * HTB)
#define PG8_STAGE(bufoff, gbase, voff) do { _Pragma("unroll") for (int _i = 0; _i < 2; ++_i) \
        __builtin_amdgcn_global_load_lds((const unsigned*)((const char*)(gbase) + (voff)[_i]), (PG8_LAS unsigned*)(lds + (bufoff) + ldsw + _i * 8192), 16, 0, 0); } while (0)
#define PG8_LDA(dst, b, h) do { _Pragma("unroll") for (int m = 0; m < 4; ++m) _Pragma("unroll") for (int k = 0; k < 2; ++k) dst[m][k] = *(const PG8_LAS bf16x8*)(lds + PG8_SA(b, h) + aoff + m * 2048 + k * 1024); } while (0)
#define PG8_LDB(dst, b, h) do { _Pragma("unroll") for (int n = 0; n < 2; ++n) _Pragma("unroll") for (int k = 0; k < 2; ++k) dst[n][k] = *(const PG8_LAS bf16x8*)(lds + PG8_SB(b, h) + boff + n * 2048 + k * 1024); } while (0)
#define PG8_MMA(ai, bj, At, Bt) do { __builtin_amdgcn_s_setprio(1); _Pragma("unroll") for (int m = 0; m < 4; ++m) _Pragma("unroll") for (int n = 0; n < 2; ++n) _Pragma("unroll") for (int k = 0; k < 2; ++k) \
        acc[ai][bj][m][n] = __builtin_amdgcn_mfma_f32_16x16x32_bf16(Bt[n][k], At[m][k], acc[ai][bj][m][n], 0, 0, 0); __builtin_amdgcn_s_setprio(0); } while (0)
#define PG8_WAIT_V(n) asm volatile("s_waitcnt vmcnt(" #n ")" ::: "memory")
#define PG8_WAIT_L(n) asm volatile("s_waitcnt lgkmcnt(" #n ")" ::: "memory")
#define PG8_BAR __builtin_amdgcn_s_barrier()
#define PG8_SCHED __builtin_amdgcn_sched_barrier(0)
    Unit cur, nxt; int ui = 0;
    if (!S.next(0, cur)) return;
    f32x4 acc[2][2][4][2];
#pragma unroll
    for (int a = 0; a < 2; ++a)
#pragma unroll
        for (int b = 0; b < 2; ++b)
#pragma unroll
            for (int m = 0; m < 4; ++m)
#pragma unroll
                for (int n = 0; n < 2; ++n) acc[a][b][m][n] = (f32x4){0.f, 0.f, 0.f, 0.f};
    bf16x8 At[4][2], B0[2][2], B1[2][2];
    const char* cA = (const char*)g.A + (size_t)cur.pm * tstep; const char* cB = (const char*)g.Bt + (size_t)cur.pn * tstep;
    S.a_ready(cur);
    if constexpr (SP2) {
        PG8_STAGE(PG8_SB(0, 0), cB, voffB); PG8_STAGE(PG8_SB(0, 1), cB + hstep, voffB); PG8_STAGE(PG8_SA(0, 0), cA, voffA); PG8_STAGE(PG8_SA(0, 1), cA + hstep, voffA);
        if (wr == 1) PG8_BAR;
        PG8_WAIT_V(2); PG8_BAR;
        PG8_STAGE(PG8_SB(1, 0), cB + kstep, voffB); PG8_STAGE(PG8_SA(1, 0), cA + kstep, voffA); PG8_STAGE(PG8_SB(1, 1), cB + hstep + kstep, voffB);
        PG8_WAIT_V(6); PG8_BAR;
    } else {
        PG8_STAGE(PG8_SB(0, 0), cB, voffB); PG8_STAGE(PG8_SA(0, 0), cA, voffA); PG8_STAGE(PG8_SB(0, 1), cB + hstep, voffB); PG8_STAGE(PG8_SA(0, 1), cA + hstep, voffA);
        if (wr == 1) PG8_BAR;
        PG8_WAIT_V(4); PG8_BAR;
        PG8_STAGE(PG8_SB(1, 0), cB + kstep, voffB); PG8_STAGE(PG8_SA(1, 0), cA + kstep, voffA); PG8_STAGE(PG8_SB(1, 1), cB + hstep + kstep, voffB);
        PG8_WAIT_V(6); PG8_BAR;
    }
    for (;;) {
        const bool has_next = S.next(ui + 1, nxt);
        const char* nA = has_next ? (const char*)g.A + (size_t)nxt.pm * tstep : cA; const char* nB = has_next ? (const char*)g.Bt + (size_t)nxt.pn * tstep : cB;
        for (int t = 0; t < nt; t += 2) {
            const bool last = (t == nt - 2);
            const char* a1 = cA + (size_t)(t + 1) * kstep;
            const char* a2 = last ? nA : cA + (size_t)(t + 2) * kstep; const char* b2 = last ? nB : cB + (size_t)(t + 2) * kstep;
            const char* a3 = a2 + kstep; const char* b3 = b2 + kstep;
            if (last && has_next) S.a_ready(nxt);
            if constexpr (SP2) {
            PG8_LDB(B0, 0, 0); PG8_LDB(B1, 0, 1); PG8_SCHED; PG8_LDA(At, 0, 0); PG8_STAGE(PG8_SA(1, 1), a1 + hstep, voffA);
            PG8_WAIT_V(8); PG8_WAIT_L(0); PG8_BAR; PG8_MMA(0, 0, At, B0); PG8_MMA(0, 1, At, B1); PG8_BAR; PG8_SCHED;
            PG8_LDA(At, 0, 1); PG8_STAGE(PG8_SB(0, 0), b2, voffB); PG8_STAGE(PG8_SB(0, 1), b2 + hstep, voffB); PG8_STAGE(PG8_SA(0, 0), a2, voffA);
            PG8_WAIT_V(8); PG8_WAIT_L(0); PG8_BAR; PG8_MMA(1, 0, At, B0); PG8_MMA(1, 1, At, B1); PG8_BAR; PG8_SCHED;
            PG8_LDB(B0, 1, 0); PG8_LDB(B1, 1, 1); PG8_SCHED; PG8_LDA(At, 1, 0); PG8_STAGE(PG8_SA(0, 1), a2 + hstep, voffA);
            PG8_WAIT_V(8); PG8_WAIT_L(0); PG8_BAR; PG8_MMA(0, 0, At, B0); PG8_MMA(0, 1, At, B1); PG8_BAR; PG8_SCHED;
            PG8_LDA(At, 1, 1); PG8_STAGE(PG8_SB(1, 0), b3, voffB); PG8_STAGE(PG8_SB(1, 1), b3 + hstep, voffB); PG8_STAGE(PG8_SA(1, 0), a3, voffA);
            PG8_WAIT_V(8); PG8_WAIT_L(0); PG8_BAR; PG8_MMA(1, 0, At, B0); PG8_MMA(1, 1, At, B1); PG8_BAR; PG8_SCHED;
            } else {
            PG8_LDB(B0, 0, 0); PG8_SCHED; PG8_LDA(At, 0, 0); PG8_STAGE(PG8_SA(1, 1), a1 + hstep, voffA);
            PG8_WAIT_L(8); PG8_BAR; PG8_WAIT_L(0); PG8_MMA(0, 0, At, B0); PG8_BAR; PG8_SCHED;
            PG8_LDB(B1, 0, 1); PG8_STAGE(PG8_SB(0, 0), b2, voffB);
            PG8_BAR; PG8_WAIT_L(0); PG8_MMA(0, 1, At, B1); PG8_BAR;
            PG8_LDA(At, 0, 1); PG8_STAGE(PG8_SA(0, 0), a2, voffA);
            PG8_BAR; PG8_WAIT_L(0); PG8_MMA(1, 0, At, B0); PG8_BAR; PG8_SCHED;
            PG8_STAGE(PG8_SB(0, 1), b2 + hstep, voffB);
            PG8_WAIT_V(6); PG8_BAR; PG8_MMA(1, 1, At, B1); PG8_BAR;
            PG8_LDB(B0, 1, 0); PG8_SCHED; PG8_LDA(At, 1, 0); PG8_STAGE(PG8_SA(0, 1), a2 + hstep, voffA);
            PG8_WAIT_L(8); PG8_BAR; PG8_WAIT_L(0); PG8_MMA(0, 0, At, B0); PG8_BAR; PG8_SCHED;
            PG8_LDB(B1, 1, 1); PG8_STAGE(PG8_SB(1, 0), b3, voffB);
            PG8_BAR; PG8_WAIT_L(0); PG8_MMA(0, 1, At, B1); PG8_BAR;
            PG8_LDA(At, 1, 1); PG8_STAGE(PG8_SA(1, 0), a3, voffA);
            PG8_BAR; PG8_WAIT_L(0); PG8_MMA(1, 0, At, B0); PG8_BAR; PG8_SCHED;
            PG8_STAGE(PG8_SB(1, 1), b3 + hstep, voffB);
            PG8_WAIT_V(6); PG8_BAR; PG8_MMA(1, 1, At, B1); PG8_BAR;
            }
        }
        if constexpr (ALIGN_EPI) { if (wr == 0) PG8_BAR; }
        if constexpr (!Epi::AFTER_DRAIN) { E(acc, cur, wr, wc, fr, fq); S.done(cur); }
        if (!has_next) break;
#pragma unroll
        for (int a = 0; a < 2; ++a)
#pragma unroll
            for (int b = 0; b < 2; ++b)
#pragma unroll
                for (int m = 0; m < 4; ++m)
#pragma unroll
                    for (int n = 0; n < 2; ++n) acc[a][b][m][n] = (f32x4){0.f, 0.f, 0.f, 0.f};
        cur = nxt; cA = nA; cB = nB; ++ui;
        if constexpr (ALIGN_EPI) { if (wr == 1) PG8_BAR; }
    }
    PG8_WAIT_V(0);
    if constexpr (!ALIGN_EPI) { if (wr == 0) PG8_BAR; }
    PG8_BAR;
    if constexpr (Epi::AFTER_DRAIN) { E.fused(acc, cur, wr, wc, fr, fq, lds, wid, lane); S.done(cur); }
#undef PG8_SA
#undef PG8_SB
#undef PG8_STAGE
#undef PG8_LDA
#undef PG8_LDB
#undef PG8_MMA
#undef PG8_WAIT_V
#undef PG8_WAIT_L
#undef PG8_BAR
#undef PG8_SCHED
}
}
#ifndef MK_N_LAUNCHES
#define MK_N_LAUNCHES 1
#endif
constexpr int NPHASE = 14;
constexpr int BATCH = 4, SEQ = 4096, D = 1024, M = BATCH * SEQ, FF = 2816, NGU = 2 * FF, NIN = 3584, DINP = 3592, NMOD = 9 * D;
constexpr float LN_EPS = 1e-5f, ALPHA = 1.189207115002721f, LOG2E = 1.4426950408889634f;
constexpr int NTHREADS = 512, NWAVES = 8;
constexpr int LDS_BYTES = 147456;
typedef unsigned short bf16;
typedef float f32x4 __attribute__((ext_vector_type(4)));
typedef float f32x16 __attribute__((ext_vector_type(16)));
typedef short bf16x8 __attribute__((ext_vector_type(8)));
typedef short s16x4 __attribute__((ext_vector_type(4)));
typedef unsigned u32x4 __attribute__((ext_vector_type(4)));
typedef unsigned u32x2 __attribute__((ext_vector_type(2)));
#define LAS __attribute__((address_space(3)))
#define LDS_WAIT() asm volatile("s_waitcnt lgkmcnt(0)" ::: "memory")

constexpr size_t MiB = 1u << 20;
constexpr size_t WS_MOD = 4 * MiB, WS_LF = 4 * MiB + 512 * 1024, WS_NB = 5 * MiB, WS_ROT = 6 * MiB;
constexpr size_t WS_WIN = 8 * MiB, WS_WWO = 15 * MiB, WS_WGU2 = 17 * MiB, WS_WD2 = 28 * MiB, WS_WGU1 = 34 * MiB, WS_WD1 = 45 * MiB;
constexpr size_t WS_ST = 34 * MiB;
constexpr size_t WS_H = 51 * MiB, WS_KV = 51 * MiB;
constexpr size_t WS_ACT = 83 * MiB;
constexpr size_t WS_FQ = 83 * MiB, WS_FK = 99 * MiB, WS_FVT = 115 * MiB, WS_RQ = 131 * MiB, WS_RK = 147 * MiB, WS_RKT = 163 * MiB, WS_RVT = 179 * MiB, WS_RG = 195 * MiB, WS_MIX = 211 * MiB;
constexpr size_t WS_END = 243 * MiB;
static_assert(WS_ACT + (size_t)M * FF * 2 <= WS_END && WS_WD1 + (size_t)D * FF * 2 <= WS_H && WS_WGU1 + (size_t)NGU * D * 2 <= WS_WD1 && WS_WD2 + (size_t)D * FF * 2 <= WS_WGU1, "ws map");

__device__ __forceinline__ unsigned f2bf(float f) { unsigned u = __builtin_bit_cast(unsigned, f); return (u + 0x7fffu + ((u >> 16) & 1u)) >> 16; }
__device__ __forceinline__ unsigned pk2(float lo, float hi) { return pg8::cvt_pk_bf16(lo, hi); }
__device__ __forceinline__ float bf2f(unsigned h) { return __builtin_bit_cast(float, h << 16); }
__device__ __forceinline__ float wave_sum(float v) {
#pragma unroll
    for (int o = 1; o < 64; o <<= 1) v += __shfl_xor(v, o);
    return v;
}
__device__ __forceinline__ float sel4(float a, float b, float c, float d, int i) { return i == 0 ? a : i == 1 ? b : i == 2 ? c : d; }

#define GAS __attribute__((address_space(1)))
typedef GAS unsigned gu32;
typedef GAS unsigned long long gu64;
#define RLX_AGENT __ATOMIC_RELAXED, __HIP_MEMORY_SCOPE_AGENT
#define LDS_WAIT() asm volatile("s_waitcnt lgkmcnt(0)" ::: "memory")
#define VM_WAIT() asm volatile("s_waitcnt vmcnt(0)" ::: "memory")
__device__ __forceinline__ unsigned long long rt() { return __builtin_amdgcn_s_memrealtime(); }
#define XB_TMO      128
#define XB_XCNT(j)  (256  + 64 * (j))
#define XB_XSUB(j)  (1280 + 64 * (j))
#define XB_XGEN(j)  (2304 + 64 * (j))
#define XB_TOP      3328
#define XB_TOPGEN   3392
#define XCD_BAR_WORDS 3456
#define XB_SPIN_CAP (1u << 18)

__device__ __forceinline__ unsigned xb_ld(unsigned* p)              { return __hip_atomic_load(p, __ATOMIC_RELAXED, __HIP_MEMORY_SCOPE_AGENT); }
__device__ __forceinline__ unsigned xb_add(unsigned* p, unsigned v) { return __hip_atomic_fetch_add(p, v, __ATOMIC_RELAXED, __HIP_MEMORY_SCOPE_AGENT); }
__device__ __forceinline__ unsigned xb_xcc_id() { return (unsigned)__builtin_amdgcn_s_getreg((3 << 11) | 20) & 0xFu; }
#define XB_SPIN(cond, bar) do { unsigned _sp = 0; while (cond) { __builtin_amdgcn_s_sleep(1); \
    if ((++_sp & 255u) == 0u) { if (xb_ld(&(bar)[XB_TMO])) break; if (_sp > XB_SPIN_CAP) { atomicAdd(&(bar)[XB_TMO], 1u); break; } } } } while (0)

struct XcdBarrier {
    unsigned* bar; unsigned x;
    volatile LAS unsigned* st;
};

__device__ __forceinline__ XcdBarrier xcd_barrier_post(unsigned* bar, volatile LAS unsigned* st) {
    XcdBarrier b; b.bar = bar; b.x = xb_xcc_id(); b.st = st;
    if (threadIdx.x == 0) (void)xb_add(&bar[XB_XCNT(b.x)], 1u);
    return b;
}
__device__ __forceinline__ void xcd_barrier_complete(unsigned* bar, unsigned x, unsigned& nloc, unsigned& nx) {
    const unsigned G = gridDim.x * gridDim.y * gridDim.z;
    unsigned sum, cnt, mine, sp = 0u;
    for (;;) {
        sum = 0u; cnt = 0u; mine = 0u;
#pragma unroll
        for (unsigned j = 0; j < 16; ++j) { const unsigned c = xb_ld(&bar[XB_XCNT(j)]); sum += c; cnt += (c > 0u) ? 1u : 0u; mine = (j == x) ? c : mine; }
        if (sum == G) break;
        __builtin_amdgcn_s_sleep(1);
        if ((++sp & 255u) == 0u) { if (xb_ld(&bar[XB_TMO])) break; if (sp > XB_SPIN_CAP) { atomicAdd(&bar[XB_TMO], 1u); break; } }
    }
    nloc = mine > 0u ? mine : 1u; nx = cnt > 0u ? cnt : 1u;
}

__device__ __forceinline__ void xcd_barrier(const XcdBarrier& b) {
    asm volatile("s_waitcnt vmcnt(0)" ::: "memory");
    __syncthreads();
    if (threadIdx.x == 0) {
        unsigned* bar = b.bar;
        __builtin_amdgcn_s_waitcnt(0);
        unsigned nloc = b.st[0], nx = b.st[1];
        if (nloc == 0u) { xcd_barrier_complete(bar, b.x, nloc, nx); b.st[0] = nloc; b.st[1] = nx; }
        const unsigned old = xb_add(&bar[XB_XSUB(b.x)], 1u);
        const unsigned gen = old / nloc;
        if (old + 1u == (gen + 1u) * nloc) {
            __builtin_amdgcn_fence(__ATOMIC_RELEASE, "agent");
            asm volatile("s_waitcnt vmcnt(0)" ::: "memory");
            const unsigned og = xb_add(&bar[XB_TOP], 1u);
            const unsigned tg = og / nx;
            if (og + 1u == (tg + 1u) * nx) xb_add(&bar[XB_TOPGEN], 1u);
            else XB_SPIN(xb_ld(&bar[XB_TOPGEN]) == tg, bar);
            __builtin_amdgcn_fence(__ATOMIC_ACQUIRE, "agent");
            xb_add(&bar[XB_XGEN(b.x)], 1u);
            asm volatile("s_waitcnt vmcnt(0)" ::: "memory");
        } else {
            XB_SPIN(xb_ld(&bar[XB_XGEN(b.x)]) == gen, bar);
            __builtin_amdgcn_fence(__ATOMIC_ACQUIRE, "agent");
            asm volatile("s_waitcnt vmcnt(0)" ::: "memory");
        }
    }
    __syncthreads();
}

__device__ __forceinline__ void transpose_item(const float* W, int ldw, int col0, int k0, bf16* WT, int K, int drow0, int dstride, float* scr, int lane) {
#pragma unroll 8
    for (int i = 0; i < 32; ++i) { const int kk = 2 * i + (lane >> 5); scr[kk * 33 + (lane & 31)] = W[(size_t)(k0 + kk) * ldw + col0 + (lane & 31)]; }
    LDS_WAIT();
    const int c = lane & 7;
#pragma unroll
    for (int j = 0; j < 4; ++j) { const int n = (lane >> 3) + 8 * j; const float* s = scr + (8 * c) * 33 + n;
        u32x4 o; o.x = pk2(s[0 * 33], s[1 * 33]); o.y = pk2(s[2 * 33], s[3 * 33]); o.z = pk2(s[4 * 33], s[5 * 33]); o.w = pk2(s[6 * 33], s[7 * 33]);
        *(u32x4*)(WT + (size_t)(drow0 + dstride * n) * K + k0 + 8 * c) = o; }
    LDS_WAIT();
}
__device__ __forceinline__ void gu_item(const float* Wg, const float* Wu, bf16* WT, int r, float* scr, int lane) {
    const int up = r >= 1408; if (up) r -= 1408;
    const int kb = r / 88, g = r % 88, n0 = 32 * g;
    transpose_item(up ? Wu : Wg, FF, n0, 64 * kb, WT, D, 256 * (n0 >> 7) + (n0 & 127) + (up ? 128 : 0), 1, scr, lane);
}
__device__ __forceinline__ void down_item(const float* Wd, bf16* WT, int r, float* scr, int lane) {
    const int kb = r >> 5, g = r & 31;
    transpose_item(Wd, D, 32 * g, 64 * kb, WT, FF, 32 * g, 1, scr, lane);
}
__device__ __forceinline__ void win_item(const float* Win, bf16* WT, int r, float* scr, int lane) {
    const int kb = r / 112, g = r % 112; int src, dst, stride = 1;
    if (g < 48) { src = 32 * g; dst = 32 * g; }
    else if (g < 80) { const int isk = g >= 64, gg = (g - 48) & 15, head = gg >> 2, half = (gg >> 1) & 1, d0 = 32 * (gg & 1);
        src = (isk ? 2056 : 1544) + head * 128 + half * 64 + d0; dst = (isk ? 2048 : 1536) + head * 128 + 2 * d0 + half; stride = 2; }
    else { src = 8 + 32 * g; dst = 32 * g; }
    transpose_item(Win, DINP, src, 64 * kb, WT, D, dst, stride, scr, lane);
}
__device__ __forceinline__ void mod_item(const float* c, const float* w_ada, const float* b_ada, float* MOD, int it, float* red, int tid, int lane, int wid) {
    float ca[4][2];
#pragma unroll
    for (int b = 0; b < 4; ++b)
#pragma unroll
        for (int hh = 0; hh < 2; ++hh) { const float cv = c[b * D + 128 * wid + 64 * hh + lane]; ca[b][hh] = cv / (1.0f + expf(-cv)); }
    float acc[4] = {0.f, 0.f, 0.f, 0.f};
    const float* wp = w_ada + (size_t)(128 * wid) * NMOD + 64 * it + lane;
#pragma unroll
    for (int hh = 0; hh < 2; ++hh) {
#pragma unroll 16
        for (int kk = 0; kk < 64; ++kk) { const float wv = wp[(size_t)(64 * hh + kk) * NMOD];
#pragma unroll
            for (int b = 0; b < 4; ++b) acc[b] += wv * __builtin_bit_cast(float, __builtin_amdgcn_readlane(__builtin_bit_cast(int, ca[b][hh]), kk)); }
    }
#pragma unroll
    for (int b = 0; b < 4; ++b) red[(wid * 4 + b) * 64 + lane] = acc[b];
    __syncthreads();
    if (tid < 256) { const int b = tid >> 6, l = tid & 63; float s = 0.f;
#pragma unroll
        for (int w = 0; w < 8; ++w) s += red[(w * 4 + b) * 64 + l];
        MOD[b * NMOD + 64 * it + l] = s + b_ada[64 * it + l]; }
    __syncthreads();
}
__device__ __forceinline__ void rot_entry(float* ROT, int i) {
    const int s = i >> 6, d = i & 63;
    const float invf = (float)exp2((double)d * -0.20762050593046014);
    const float ang = (float)s * invf;
    const double a = (double)ang, n = rint(a * 0.6366197723675814);
    double r = fma(-n, 1.5707963267948966, a); r = fma(-n, 6.123233995736766e-17, r);
    const double r2 = r * r;
    const double sn = r * (1.0 + r2 * (-1.0 / 6 + r2 * (1.0 / 120 + r2 * (-1.0 / 5040 + r2 * (1.0 / 362880 + r2 * (-1.0 / 39916800 + r2 * (1.0 / 6227020800.0)))))));
    const double cs = 1.0 + r2 * (-0.5 + r2 * (1.0 / 24 + r2 * (-1.0 / 720 + r2 * (1.0 / 40320 + r2 * (-1.0 / 3628800 + r2 * (1.0 / 479001600.0 + r2 * (-1.0 / 87178291200.0)))))));
    const int q = ((int)n) & 3;
    const double C = (q == 0) ? cs : (q == 1) ? -sn : (q == 2) ? -cs : sn;
    const double S = (q == 0) ? sn : (q == 1) ? cs : (q == 2) ? -sn : -cs;
    ROT[2 * i] = (float)C; ROT[2 * i + 1] = (float)S;
}

__device__ __forceinline__ void modulate_pass(const float* x, const float* MOD, bf16* H, int gw, int NGW, int lane) {
    for (int m = gw; m < M; m += NGW) {
        const float* mod = MOD + (size_t)(m >> 12) * NMOD;
#pragma unroll
        for (int j = 0; j < 4; ++j) { const int col = 4 * lane + 256 * j;
            const f32x4 xv = *(const f32x4*)(x + (size_t)m * D + col), sh = *(const f32x4*)(mod + col), sc = *(const f32x4*)(mod + D + col);
            const f32x4 h = xv * (sc + 1.0f) + sh;
            u32x2 w; w.x = pk2(h[0], h[1]); w.y = pk2(h[2], h[3]); *(u32x2*)(H + (size_t)m * D + col) = w; }
    }
}
template <bool HAS_H, bool HAS_LF>
__device__ __forceinline__ void ln_pass(float* X, const float* g, const float* bt, const float* MOD, int moff, bf16* H, const float* WFs, const float* fox_b, float* LF, int gw, int NGW, int lane) {
    f32x4 gv[4], bv[4];
#pragma unroll
    for (int j = 0; j < 4; ++j) { gv[j] = *(const f32x4*)(g + 4 * lane + 256 * j); bv[j] = *(const f32x4*)(bt + 4 * lane + 256 * j); }
    for (int m = gw; m < M; m += NGW) {
        float* xr = X + (size_t)m * D;
        f32x4 v[4]; float s = 0.f;
#pragma unroll
        for (int j = 0; j < 4; ++j) { v[j] = *(const f32x4*)(xr + 4 * lane + 256 * j); s += (v[j][0] + v[j][1]) + (v[j][2] + v[j][3]); }
        const float mean = wave_sum(s) * (1.f / D); float s2 = 0.f;
#pragma unroll
        for (int j = 0; j < 4; ++j) { v[j] = v[j] - mean; s2 += (v[j][0] * v[j][0] + v[j][1] * v[j][1]) + (v[j][2] * v[j][2] + v[j][3] * v[j][3]); }
        const float rstd = 1.f / sqrtf(wave_sum(s2) * (1.f / D) + LN_EPS);
#pragma unroll
        for (int j = 0; j < 4; ++j) { v[j] = v[j] * rstd * gv[j] + bv[j]; *(f32x4*)(xr + 4 * lane + 256 * j) = v[j]; }
        if (HAS_H) {
            const float* mod = MOD + (size_t)(m >> 12) * NMOD + moff;
#pragma unroll
            for (int j = 0; j < 4; ++j) { const int col = 4 * lane + 256 * j;
                const f32x4 sh = *(const f32x4*)(mod + col), sc = *(const f32x4*)(mod + D + col);
                v[j] = v[j] * (sc + 1.0f) + sh;
                u32x2 w; w.x = pk2(v[j][0], v[j][1]); w.y = pk2(v[j][2], v[j][3]); *(u32x2*)(H + (size_t)m * D + col) = w; }
            if (HAS_LF) {
                float mine = 0.f;
#pragma unroll
                for (int hd = 0; hd < 8; ++hd) { float p = 0.f;
#pragma unroll
                    for (int j = 0; j < 4; ++j) { const f32x4 w = *(const f32x4*)(WFs + hd * D + 4 * lane + 256 * j); p += (v[j][0] * w[0] + v[j][1] * w[1]) + (v[j][2] * w[2] + v[j][3] * w[3]); }
                    p = wave_sum(p); if (lane == hd) mine = p; }
                if (lane < 8) { const float z = mine + fox_b[lane];
                    const float ls = fminf(z, 0.f) - log1pf(expf(-fabsf(z)));
                    LF[((size_t)(m >> 12) * 8 + lane) * SEQ + (m & 4095)] = ls; }
            }
        }
    }
}
__device__ __forceinline__ void cumsum_seq(const float* LF, float* NB, int sq, float* red, int tid, int lane, int wid) {
    const float* p = LF + (size_t)sq * SEQ + 8 * tid;
    const f32x4 a = *(const f32x4*)p, b = *(const f32x4*)(p + 4);
    float e[8]; e[0] = a[0]; e[1] = e[0] + a[1]; e[2] = e[1] + a[2]; e[3] = e[2] + a[3]; e[4] = e[3] + b[0]; e[5] = e[4] + b[1]; e[6] = e[5] + b[2]; e[7] = e[6] + b[3];
    float inc = e[7];
#pragma unroll
    for (int o = 1; o < 64; o <<= 1) { const float t = __shfl_up(inc, o); if (lane >= o) inc += t; }
    if (lane == 63) red[wid] = inc;
    __syncthreads();
    float off = inc - e[7];
    for (int w = 0; w < wid; ++w) off += red[w];
    f32x4 o0, o1;
    o0[0] = -(off + e[0]) * LOG2E; o0[1] = -(off + e[1]) * LOG2E; o0[2] = -(off + e[2]) * LOG2E; o0[3] = -(off + e[3]) * LOG2E;
    o1[0] = -(off + e[4]) * LOG2E; o1[1] = -(off + e[5]) * LOG2E; o1[2] = -(off + e[6]) * LOG2E; o1[3] = -(off + e[7]) * LOG2E;
    float* q = NB + (size_t)sq * SEQ + 8 * tid; *(f32x4*)q = o0; *(f32x4*)(q + 4) = o1;
    __syncthreads();
}

#define MFMA16(a, b, c) __builtin_amdgcn_mfma_f32_16x16x32_bf16((a), (b), (c), 0, 0, 0)
#define MFMA32(a, b, c) __builtin_amdgcn_mfma_f32_32x32x16_bf16((a), (b), (c), 0, 0, 0)
__device__ __forceinline__ void ret_kv_unit(const bf16* RVT, const bf16* RKT, float* KV, int bh, int j, int lane, int wid) {
    const int fr = lane & 15, fq = lane >> 4;
    bf16x8 af[4];
#pragma unroll
    for (int ks = 0; ks < 4; ++ks) af[ks] = *(const bf16x8*)(RVT + ((size_t)bh * 128 + 16 * wid + fr) * SEQ + 128 * j + 32 * ks + 8 * fq);
    float* out = KV + ((size_t)bh * 32 + j) * 16384 + (16 * wid + fr) * 128 + 4 * fq;
#pragma unroll
    for (int nb = 0; nb < 8; ++nb) { f32x4 acc = {0.f, 0.f, 0.f, 0.f};
#pragma unroll
        for (int ks = 0; ks < 4; ++ks) { const bf16x8 bfv = *(const bf16x8*)(RKT + ((size_t)bh * 128 + 16 * nb + fr) * SEQ + 128 * j + 32 * ks + 8 * fq); acc = MFMA16(bfv, af[ks], acc); }
        *(f32x4*)(out + 16 * nb) = acc; }
}
__device__ __forceinline__ void ret_scan(const float* KV, bf16* ST, int gtid, int NT, float l0, float l1, float l2, float l3) {
    for (int i = gtid; i < 16 * 4096; i += NT) {
        const int bh = i >> 12, e4 = (i & 4095) * 4;
        const float cd = __builtin_amdgcn_exp2f(sel4(l0, l1, l2, l3, bh & 3) * 128.0f);
        f32x4 s = {0.f, 0.f, 0.f, 0.f};
        for (int j = 0; j < 32; ++j) { const size_t o = ((size_t)bh * 32 + j) * 16384 + e4;
            u32x2 w; w.x = pk2(s[0], s[1]); w.y = pk2(s[2], s[3]); *(u32x2*)(ST + o) = w;
            const f32x4 kv = *(const f32x4*)(KV + o); s = s * cd + kv; }
    }
}
__device__ __forceinline__ void ret_out_unit(unsigned char* lds, int bh, int ci, const bf16* RQ, const bf16* RK, const bf16* RVT, const bf16* ST, const bf16* RG,
                                             const float* gn_g, const float* gn_b, bf16* MIX, float lg2, int lane, int wid) {
    const int fr = lane & 15, fq = lane >> 4, b = bh >> 2, h = bh & 3;
    const size_t row = (size_t)b * SEQ + ci * 128 + wid * 16 + fr;
    bf16* Sp = (bf16*)lds + wid * (16 * 136);
    bf16x8 qf[4];
#pragma unroll
    for (int ks = 0; ks < 4; ++ks) qf[ks] = *(const bf16x8*)(RQ + row * 512 + h * 128 + 32 * ks + 8 * fq);
    f32x4 acc[8];
#pragma unroll
    for (int nb = 0; nb < 8; ++nb) { acc[nb] = (f32x4){0.f, 0.f, 0.f, 0.f};
#pragma unroll
        for (int ks = 0; ks < 4; ++ks) { const bf16x8 kf = *(const bf16x8*)(RK + ((size_t)b * SEQ + ci * 128 + 16 * nb + fr) * 512 + h * 128 + 32 * ks + 8 * fq); acc[nb] = MFMA16(kf, qf[ks], acc[nb]); } }
    const int rt = wid * 16 + fr;
#pragma unroll
    for (int nb = 0; nb < 8; ++nb) { const int j0 = 16 * nb + 4 * fq; float v[4];
#pragma unroll
        for (int e = 0; e < 4; ++e) { const int diff = rt - (j0 + e); v[e] = diff >= 0 ? acc[nb][e] * __builtin_amdgcn_exp2f(lg2 * (float)diff) : 0.f; }
        u32x2 w; w.x = pk2(v[0], v[1]); w.y = pk2(v[2], v[3]); *(u32x2*)(Sp + fr * 136 + j0) = w; }
    LDS_WAIT();
    bf16x8 sf[4];
#pragma unroll
    for (int ks = 0; ks < 4; ++ks) sf[ks] = *(const bf16x8*)(Sp + fr * 136 + 32 * ks + 8 * fq);
    LDS_WAIT();
    const bf16* STp = ST + ((size_t)bh * 32 + ci) * 16384;
#pragma unroll
    for (int nb = 0; nb < 8; ++nb) { acc[nb] = (f32x4){0.f, 0.f, 0.f, 0.f};
#pragma unroll
        for (int ks = 0; ks < 4; ++ks) { const bf16x8 bfv = *(const bf16x8*)(STp + (16 * nb + fr) * 128 + 32 * ks + 8 * fq); acc[nb] = MFMA16(bfv, qf[ks], acc[nb]); } }
    const float qd = __builtin_amdgcn_exp2f(lg2 * (float)(rt + 1));
#pragma unroll
    for (int nb = 0; nb < 8; ++nb) { acc[nb] = acc[nb] * qd;
#pragma unroll
        for (int ks = 0; ks < 4; ++ks) { const bf16x8 vf = *(const bf16x8*)(RVT + ((size_t)bh * 128 + 16 * nb + fr) * SEQ + ci * 128 + 32 * ks + 8 * fq); acc[nb] = MFMA16(vf, sf[ks], acc[nb]); } }
    float s = 0.f;
#pragma unroll
    for (int nb = 0; nb < 8; ++nb) s += (acc[nb][0] + acc[nb][1]) + (acc[nb][2] + acc[nb][3]);
    s += __shfl_xor(s, 16); s += __shfl_xor(s, 32);
    const float mean = s * (1.f / 128.f); float q = 0.f;
#pragma unroll
    for (int nb = 0; nb < 8; ++nb) { acc[nb] = acc[nb] - mean; q += (acc[nb][0] * acc[nb][0] + acc[nb][1] * acc[nb][1]) + (acc[nb][2] * acc[nb][2] + acc[nb][3] * acc[nb][3]); }
    q += __shfl_xor(q, 16); q += __shfl_xor(q, 32);
    const float rstd = 1.f / sqrtf(q * (1.f / 128.f) + LN_EPS);
#pragma unroll
    for (int nb = 0; nb < 8; ++nb) { const int c = h * 128 + 16 * nb + 4 * fq;
        const f32x4 g = *(const f32x4*)(gn_g + c), bb = *(const f32x4*)(gn_b + c);
        const u32x2 rg = *(const u32x2*)(RG + row * 512 + c);
        const f32x4 gate = {bf2f(rg.x & 0xffffu), bf2f(rg.x >> 16), bf2f(rg.y & 0xffffu), bf2f(rg.y >> 16)};
        const f32x4 o = (acc[nb] * rstd * g + bb) * gate;
        u32x2 w; w.x = pk2(o[0], o[1]); w.y = pk2(o[2], o[3]); *(u32x2*)(MIX + row * 1024 + 512 + c) = w; }
}

__device__ __forceinline__ int crow(int r, int hi) { return (r & 3) + 8 * (r >> 2) + 4 * hi; }
constexpr int KP = 72, VP = 68;
constexpr int FOX_K = 0, FOX_V = 2 * 64 * KP * 2, FOX_NB = FOX_V + 2 * 64 * VP * 2;
__device__ __forceinline__ void fox_unit(unsigned char* lds, int b, int h, int qb, const bf16* FQ, const bf16* FK, const bf16* FVT, const float* NBg, bf16* MIX, int tid, int lane, int wid) {
    const int r32 = lane & 31, hi = lane >> 5;
    bf16* Ks = (bf16*)(lds + FOX_K); bf16* Vs = (bf16*)(lds + FOX_V); float* nb = (float*)(lds + FOX_NB);
    const int q0 = qb * 256, NT = 4 * qb + 4;
    { const float* src = NBg + (size_t)(b * 8 + h) * SEQ;
      for (int i = tid * 4; i < q0 + 256; i += NTHREADS * 4) *(f32x4*)(nb + i) = *(const f32x4*)(src + i); }
    const size_t qrow = (size_t)b * SEQ + q0 + wid * 32 + r32;
    bf16x8 qf[4];
#pragma unroll
    for (int d0 = 0; d0 < 4; ++d0) qf[d0] = *(const bf16x8*)(FQ + qrow * 512 + h * 64 + d0 * 16 + hi * 8);
    const int skey = tid >> 3, sch = tid & 7;
    const bf16* kg = FK + ((size_t)b * SEQ + skey) * 512 + h * 64 + sch * 8;
    const bf16* vg = FVT + ((size_t)(b * 8 + h) * 64 + skey) * SEQ + sch * 8;
    u32x4 kr = *(const u32x4*)kg, vr = *(const u32x4*)vg;
    *(u32x4*)(Ks + skey * KP + sch * 8) = kr;
    { u32x2 lo = {vr.x, vr.y}, hi2 = {vr.z, vr.w}; *(u32x2*)(Vs + skey * VP + sch * 8) = lo; *(u32x2*)(Vs + skey * VP + sch * 8 + 4) = hi2; }
    __syncthreads();
    float m_run = -INFINITY, l_run = 0.f;
    f32x16 oT[2]; oT[0] = f32x16{}; oT[1] = f32x16{};
    const int my_last = 4 * qb + (wid >> 1);
    const int qg = q0 + wid * 32 + r32;
    for (int t = 0; t < NT; ++t) {
        const int cur = t & 1;
        if (t + 1 < NT) { kr = *(const u32x4*)(kg + (size_t)(t + 1) * 64 * 512); vr = *(const u32x4*)(vg + (t + 1) * 64); }
        if (t <= my_last) {
            const bf16* Kb = Ks + cur * 64 * KP; const bf16* Vb = Vs + cur * 64 * VP;
            f32x16 p0 = f32x16{}, p1 = f32x16{};
#pragma unroll
            for (int d0 = 0; d0 < 4; ++d0) {
                const bf16x8 a0 = *(const bf16x8*)(Kb + r32 * KP + d0 * 16 + hi * 8), a1 = *(const bf16x8*)(Kb + (32 + r32) * KP + d0 * 16 + hi * 8);
                p0 = MFMA32(a0, qf[d0], p0); p1 = MFMA32(a1, qf[d0], p1); }
            const int kv0 = t * 64;
#pragma unroll
            for (int g = 0; g < 4; ++g) { const f32x4 b0 = *(const f32x4*)(nb + kv0 + 8 * g + 4 * hi), b1 = *(const f32x4*)(nb + kv0 + 32 + 8 * g + 4 * hi);
#pragma unroll
                for (int e = 0; e < 4; ++e) { p0[4 * g + e] += b0[e]; p1[4 * g + e] += b1[e]; } }
            if (t >= 4 * qb) {
#pragma unroll
                for (int r = 0; r < 16; ++r) { const int kv = kv0 + crow(r, hi); if (kv > qg) p0[r] = -INFINITY; if (kv + 32 > qg) p1[r] = -INFINITY; }
            }
            float mx = fmaxf(p0[0], p1[0]);
#pragma unroll
            for (int r = 1; r < 16; ++r) mx = fmaxf(mx, fmaxf(p0[r], p1[r]));
            mx = fmaxf(mx, __shfl_xor(mx, 32));
            const float m_new = fmaxf(m_run, mx);
            const float alpha = __builtin_amdgcn_exp2f(m_run - m_new);
            m_run = m_new;
            float sum = 0.f;
#pragma unroll
            for (int r = 0; r < 16; ++r) { p0[r] = __builtin_amdgcn_exp2f(p0[r] - m_new); p1[r] = __builtin_amdgcn_exp2f(p1[r] - m_new); sum += p0[r] + p1[r]; }
            l_run = l_run * alpha + sum;
#pragma unroll
            for (int r = 0; r < 16; ++r) { oT[0][r] *= alpha; oT[1][r] *= alpha; }
            u32x4 pb[2][2];
#pragma unroll
            for (int ks = 0; ks < 2; ++ks) {
                pb[0][ks] = (u32x4){pk2(p0[8 * ks + 0], p0[8 * ks + 1]), pk2(p0[8 * ks + 2], p0[8 * ks + 3]), pk2(p0[8 * ks + 4], p0[8 * ks + 5]), pk2(p0[8 * ks + 6], p0[8 * ks + 7])};
                pb[1][ks] = (u32x4){pk2(p1[8 * ks + 0], p1[8 * ks + 1]), pk2(p1[8 * ks + 2], p1[8 * ks + 3]), pk2(p1[8 * ks + 4], p1[8 * ks + 5]), pk2(p1[8 * ks + 6], p1[8 * ks + 7])}; }
#pragma unroll
            for (int dblk = 0; dblk < 2; ++dblk)
#pragma unroll
                for (int half = 0; half < 2; ++half)
#pragma unroll
                    for (int ks = 0; ks < 2; ++ks) {
                        const bf16* va = Vb + (32 * dblk + r32) * VP + 32 * half + 16 * ks + 4 * hi;
                        const s16x4 lo = *(const s16x4*)va, hi4 = *(const s16x4*)(va + 8);
                        const bf16x8 A = {lo[0], lo[1], lo[2], lo[3], hi4[0], hi4[1], hi4[2], hi4[3]};
                        oT[dblk] = MFMA32(A, __builtin_bit_cast(bf16x8, pb[half][ks]), oT[dblk]); }
        }
        if (t + 1 < NT) {
            bf16* Kw = Ks + (cur ^ 1) * 64 * KP; bf16* Vw = Vs + (cur ^ 1) * 64 * VP;
            *(u32x4*)(Kw + skey * KP + sch * 8) = kr;
            u32x2 lo = {vr.x, vr.y}, hi2 = {vr.z, vr.w}; *(u32x2*)(Vw + skey * VP + sch * 8) = lo; *(u32x2*)(Vw + skey * VP + sch * 8 + 4) = hi2;
        }
        __syncthreads();
    }
    l_run += __shfl_xor(l_run, 32);
    const float inv = 1.0f / l_run;
    bf16* orow = MIX + qrow * 1024 + h * 64;
#pragma unroll
    for (int dblk = 0; dblk < 2; ++dblk)
#pragma unroll
        for (int g = 0; g < 4; ++g) { u32x2 w; w.x = pk2(oT[dblk][4 * g] * inv, oT[dblk][4 * g + 1] * inv); w.y = pk2(oT[dblk][4 * g + 2] * inv, oT[dblk][4 * g + 3] * inv);
            *(u32x2*)(orow + 32 * dblk + 8 * g + 4 * hi) = w; }
}

struct Args { const float* in[21]; float* out; unsigned char* ws; float lg2g[4]; int ph_lo, ph_hi; };
__global__ void __launch_bounds__(NTHREADS, 2) fwd_megakernel(Args args) {
    extern __shared__ __attribute__((aligned(16))) unsigned char lds[];
    cg::grid_group grid = cg::this_grid();
    const int tid = threadIdx.x, lane = tid & 63, wid = __builtin_amdgcn_readfirstlane(tid >> 6);
    const int G = gridDim.x, blk = blockIdx.x;
    const int gw = blk * NWAVES + wid, NGW = G * NWAVES, gtid = blk * NTHREADS + tid, NT = G * NTHREADS;
    unsigned char* ws = args.ws;
    const float* x = args.in[0];
    float* OUT = args.out;
    float* MOD = (float*)(ws + WS_MOD); float* LF = (float*)(ws + WS_LF); float* NB = (float*)(ws + WS_NB); float* ROT = (float*)(ws + WS_ROT);
    bf16* W_IN = (bf16*)(ws + WS_WIN); bf16* W_WO = (bf16*)(ws + WS_WWO); bf16* W_GU2 = (bf16*)(ws + WS_WGU2); bf16* W_D2 = (bf16*)(ws + WS_WD2);
    bf16* W_GU1 = (bf16*)(ws + WS_WGU1); bf16* W_D1 = (bf16*)(ws + WS_WD1); bf16* ST = (bf16*)(ws + WS_ST);
    bf16* H = (bf16*)(ws + WS_H); float* KV = (float*)(ws + WS_KV); bf16* ACT = (bf16*)(ws + WS_ACT);
    bf16* FQ = (bf16*)(ws + WS_FQ); bf16* FK = (bf16*)(ws + WS_FK); bf16* FVT = (bf16*)(ws + WS_FVT); bf16* RQ = (bf16*)(ws + WS_RQ); bf16* RK = (bf16*)(ws + WS_RK);
    bf16* RKT = (bf16*)(ws + WS_RKT); bf16* RVT = (bf16*)(ws + WS_RVT); bf16* RG = (bf16*)(ws + WS_RG); bf16* MIX = (bf16*)(ws + WS_MIX);
    const float l0 = args.lg2g[0], l1 = args.lg2g[1], l2 = args.lg2g[2], l3 = args.lg2g[3];
    const int lo = args.ph_lo, hi = args.ph_hi;
#define IN(k) (lo <= (k) && (k) < hi)
#ifndef PROBE_SYNCS
#define PROBE_SYNCS 1
#endif
#define SEAM(k) do { if (IN(k) && IN((k) + 1)) { for (int _s = 0; _s < PROBE_SYNCS; ++_s) xcd_barrier(bar); } } while (0)
    PG8_LAS unsigned char* ldsp = (PG8_LAS unsigned char*)lds;
    volatile LAS unsigned* bst = (volatile LAS unsigned*)(ldsp + LDS_BYTES - 64);
    if (tid < 4) bst[tid] = 0u;
    __syncthreads();
    XcdBarrier bar = xcd_barrier_post((unsigned*)ws, bst);
    if (hi > NPHASE) grid.sync();

    if (IN(0)) {
        for (int it = blk; it < NMOD / 64; it += G) mod_item(args.in[1], args.in[2], args.in[3], MOD, it, (float*)lds, tid, lane, wid);
        for (int i = gtid; i < SEQ * 64; i += NT) rot_entry(ROT, i);
        float* scr = (float*)(lds + 16384 + wid * 16384);
        constexpr int I_GU = 2816, I_D = 1408, I_IN = 1792, I_WO = 512, NITEMS = 2 * I_GU + 2 * I_D + I_IN + I_WO;
        for (int it = gw; it < NITEMS; it += NGW) {
            int r = it;
            if (r < I_GU) { gu_item(args.in[4], args.in[5], W_GU1, r, scr, lane); continue; } r -= I_GU;
            if (r < I_D) { down_item(args.in[6], W_D1, r, scr, lane); continue; } r -= I_D;
            if (r < I_IN) { win_item(args.in[9], W_IN, r, scr, lane); continue; } r -= I_IN;
            if (r < I_WO) { transpose_item(args.in[13], D, 32 * (r & 31), 64 * (r >> 5), W_WO, D, 32 * (r & 31), 1, scr, lane); continue; } r -= I_WO;
            if (r < I_GU) { gu_item(args.in[16], args.in[17], W_GU2, r, scr, lane); continue; } r -= I_GU;
            down_item(args.in[18], W_D2, r, scr, lane);
        }
    }
    SEAM(0);
    if (IN(1)) modulate_pass(x, MOD, H, gw, NGW, lane);
    SEAM(1);
    if (IN(2)) { pg8::Gemm g{H, W_GU1, M, NGU, D}; pg8::StaticOrder S; S.init(M, NGU, G, blk); pg8::EpiSwiglu E{ACT, FF};
        pg8::gemm_phase<pg8::EpiSwiglu, pg8::StaticOrder, true, true>(ldsp, g, S, E); }
    SEAM(2);
    if (IN(3)) { pg8::Gemm g{ACT, W_D1, M, D, FF}; pg8::StaticOrder S; S.init(M, D, G, blk); pg8::EpiResid E{x, OUT, MOD + 2 * D, ALPHA, 0.5f, SEQ, NMOD};
        pg8::gemm_phase<pg8::EpiResid, pg8::StaticOrder, true, true>(ldsp, g, S, E); }
    SEAM(3);
    if (IN(4)) {
        float* WFs = (float*)lds;
        for (int i = tid; i < 8 * D; i += NTHREADS) { const int k = i >> 3, hd = i & 7; WFs[hd * D + k] = args.in[9][(size_t)k * DINP + 1536 + hd]; }
        __syncthreads();
        ln_pass<true, true>(OUT, args.in[7], args.in[8], MOD, 3 * D, H, WFs, args.in[10], LF, gw, NGW, lane);
        __syncthreads();
    }
    SEAM(4);
    if (IN(5)) {
        for (int sq = blk; sq < BATCH * 8; sq += G) cumsum_seq(LF, NB, sq, (float*)lds, tid, lane, wid);
        pg8::Gemm g{H, W_IN, M, NIN, D}; pg8::StaticOrder S; S.init(M, NIN, G, blk);
        pg8::EpiInProj E{FQ, FK, FVT, RQ, RK, RKT, RVT, RG, ROT, l0, l1, l2, l3};
        pg8::gemm_phase<pg8::EpiInProj, pg8::StaticOrder, true, true>(ldsp, g, S, E);
    }
    SEAM(5);
    if (IN(6)) { for (int u = blk; u < 512; u += G) ret_kv_unit(RVT, RKT, KV, u >> 5, u & 31, lane, wid); }
    SEAM(6);
    if (IN(7)) {
        ret_scan(KV, ST, gtid, NT, l0, l1, l2, l3);
        for (int it = blk; it < 512; it += G) { const int i2 = it & 255, bh = i2 >> 3, s = i2 & 7, qb = (it < 256) ? 15 - s : s;
            fox_unit(lds, bh >> 3, bh & 7, qb, FQ, FK, FVT, NB, MIX, tid, lane, wid); }
    }
    SEAM(7);
    if (IN(8)) { for (int u = blk; u < 512; u += G) { const int bh = u >> 5; ret_out_unit(lds, bh, u & 31, RQ, RK, RVT, ST, RG, args.in[11], args.in[12], MIX, sel4(l0, l1, l2, l3, bh & 3), lane, wid); } }
    SEAM(8);
    if (IN(9)) { pg8::Gemm g{MIX, W_WO, M, D, D}; pg8::StaticOrder S; S.init(M, D, G, blk); pg8::EpiResid E{OUT, OUT, MOD + 5 * D, ALPHA, 1.0f, SEQ, NMOD};
        pg8::gemm_phase<pg8::EpiResid, pg8::StaticOrder, true, true>(ldsp, g, S, E); }
    SEAM(9);
    if (IN(10)) ln_pass<true, false>(OUT, args.in[14], args.in[15], MOD, 6 * D, H, nullptr, nullptr, nullptr, gw, NGW, lane);
    SEAM(10);
    if (IN(11)) { pg8::Gemm g{H, W_GU2, M, NGU, D}; pg8::StaticOrder S; S.init(M, NGU, G, blk); pg8::EpiSwiglu E{ACT, FF};
        pg8::gemm_phase<pg8::EpiSwiglu, pg8::StaticOrder, true, true>(ldsp, g, S, E); }
    SEAM(11);
    if (IN(12)) { pg8::Gemm g{ACT, W_D2, M, D, FF}; pg8::StaticOrder S; S.init(M, D, G, blk); pg8::EpiResid E{OUT, OUT, MOD + 8 * D, ALPHA, 0.5f, SEQ, NMOD};
        pg8::gemm_phase<pg8::EpiResid, pg8::StaticOrder, true, true>(ldsp, g, S, E); }
    SEAM(12);
    if (IN(13)) ln_pass<false, false>(OUT, args.in[19], args.in[20], nullptr, 0, nullptr, nullptr, nullptr, nullptr, gw, NGW, lane);
#undef IN
#undef SEAM
}

extern "C" void kernel_launch(void* const* d_in, const int* in_sizes, int n_in, void* d_out, int out_size, void* d_ws, size_t ws_size, hipStream_t stream) {
    static int grid = 0;
    if (grid == 0) {
        if (n_in != 21 || out_size != M * D || ws_size < WS_END) { fprintf(stderr, "kernel_launch: unexpected problem geometry (n_in %d, out %d, ws %zu)\n", n_in, out_size, ws_size); grid = -1; return; }
        int dev = 0, cus = 0, per_cu = 0;
        hipGetDevice(&dev); hipDeviceGetAttribute(&cus, hipDeviceAttributeMultiprocessorCount, dev);
        if (hipFuncSetAttribute((const void*)fwd_megakernel, hipFuncAttributeMaxDynamicSharedMemorySize, LDS_BYTES) != hipSuccess) { fprintf(stderr, "kernel_launch: hipFuncSetAttribute failed\n"); grid = -1; return; }
        if (hipOccupancyMaxActiveBlocksPerMultiprocessor(&per_cu, (const void*)fwd_megakernel, NTHREADS, LDS_BYTES) != hipSuccess || per_cu < 1) { fprintf(stderr, "kernel_launch: occupancy query says %d\n", per_cu); per_cu = 1; }
        (void)hipGetLastError();
        grid = cus * per_cu;
    }
    if (grid < 0) return;
    if (hipMemsetAsync(d_ws, 0, 16384, stream) != hipSuccess) { fprintf(stderr, "kernel_launch: memset failed\n"); return; }
    Args a{};
    for (int i = 0; i < 21; ++i) a.in[i] = (const float*)d_in[i];
    a.out = (float*)d_out; a.ws = (unsigned char*)d_ws;
    for (int h = 0; h < 4; ++h) a.lg2g[h] = (float)std::log2(1.0 - std::pow(2.0, -5.0 - h));
#if MK_N_LAUNCHES == 1
    a.ph_lo = 0; a.ph_hi = NPHASE;
    void* kargs[] = {&a};
    hipError_t e = hipLaunchCooperativeKernel((const void*)fwd_megakernel, dim3(grid), dim3(NTHREADS), kargs, LDS_BYTES, stream);
    if (e != hipSuccess) fprintf(stderr, "kernel_launch: cooperative launch failed: %s (grid %d)\n", hipGetErrorString(e), grid);
#else
    for (int p = 0; p < NPHASE; ++p) { a.ph_lo = p; a.ph_hi = p + 1; hipLaunchKernelGGL(fwd_megakernel, dim3(grid), dim3(NTHREADS), LDS_BYTES, stream, a); }
#endif
}
```

```cpp
#include <hip/hip_runtime.h>
#include <hip/hip_cooperative_groups.h>
#include <cstdio>
#include <cstdint>
#include <cmath>
namespace cg = cooperative_groups;
__device__ __forceinline__ int mk_lane() { int l; asm volatile("v_mbcnt_lo_u32_b32 %0, -1, 0\n\tv_mbcnt_hi_u32_b32 %0, -1, %0" : "=v"(l)); return l; }
namespace pg8 {
#define PG8_LAS __attribute__((address_space(3)))
typedef unsigned short bf16_t;
typedef short bf16x8 __attribute__((ext_vector_type(8)));
typedef float f32x4 __attribute__((ext_vector_type(4)));
typedef unsigned u32x4 __attribute__((ext_vector_type(4)));
constexpr int BM = 256, BK = 64, HALF = 128, HTB = HALF * BK * 2  , STAGE_BYTES = 8 * HTB, NXCD = 8, WGM = 8;

__host__ __device__ __forceinline__ int lds_byte(int r, int c) { const int st = (r >> 4) * 2 + (c >> 5), rr = r & 15, cc = c & 31, ob = rr * 64 + cc * 2; return st * 1024 + (ob ^ (((ob >> 9) & 1) << 5)); }
__host__ __device__ __forceinline__ void stage_rc(int b, int& R, int& C) { const int st = b / 1024, sb = b % 1024, swz = sb ^ (((sb >> 9) & 1) << 5); R = (st >> 1) * 16 + swz / 64; C = (st & 1) * 32 + (swz % 64) / 2; }
__host__ __device__ __forceinline__ int perm32(int rho) { const int n = rho >> 4, i = rho & 15; return 8 * (i >> 2) + 4 * n + (i & 3); }

struct Unit { int pm, pn; };
struct Gemm { const bf16_t* A; const bf16_t* Bt; int M, N, K; };

struct StaticOrder {
    int nM, nN, nwg, G, c;
    __host__ __device__ void init(int M, int N, int G_, int c_) { nM = M / BM; nN = N / BM; nwg = nM * nN; G = G_; c = c_; }
    __host__ __device__ bool next(int i, Unit& u) const {
        const long L = (long)i * G + c; if (L >= nwg) return false;
        int wgid = (int)L; { const int q = nwg / NXCD, r = nwg % NXCD, xcd = wgid % NXCD, off = wgid / NXCD; wgid = (xcd < r ? xcd * (q + 1) : r * (q + 1) + (xcd - r) * q) + off; }
        const int nig = WGM * nN, gid = wgid / nig, fm = gid * WGM, gsz = (nM - fm) < WGM ? (nM - fm) : WGM;
        u.pm = fm + ((wgid % nig) % gsz); u.pn = (wgid % nig) / gsz; return true;
    }
    __device__ __forceinline__ void a_ready(const Unit&) const {}
    __device__ __forceinline__ void done(const Unit&) const {}
};

__device__ __forceinline__ unsigned cvt_pk_bf16(float lo, float hi) { unsigned r; asm volatile("v_cvt_pk_bf16_f32 %0, %1, %2" : "=v"(r) : "v"(lo), "v"(hi)); return r; }
typedef float f32x2 __attribute__((ext_vector_type(2)));
typedef unsigned u32x2 __attribute__((ext_vector_type(2)));
__device__ __forceinline__ float silu_f(float g) { return g * __builtin_amdgcn_rcpf(1.0f + __builtin_amdgcn_exp2f(-1.4426950408889634f * g)); }

struct EpiSwiglu {
    static constexpr bool PERM = true, AFTER_DRAIN = false;
    bf16_t* O; int ldc;
    __device__ __forceinline__ void operator()(const f32x4 (&acc)[2][2][4][2], const Unit& u, int wr, int wc, int fr, int fq) const {
        const int row0 = u.pm * BM + wr * 64 + fr, col0 = u.pn * HALF + wc * 32 + 8 * fq;
#pragma unroll
        for (int ai = 0; ai < 2; ++ai)
#pragma unroll
            for (int m = 0; m < 4; ++m) {
                bf16_t* rowp = O + (size_t)(row0 + ai * HALF + m * 16) * ldc + col0;
                const f32x4 g0 = acc[ai][0][m][0], g1 = acc[ai][0][m][1], u0 = acc[ai][1][m][0], u1 = acc[ai][1][m][1];
                u32x4 w;
                w.x = cvt_pk_bf16(silu_f(g0[0]) * u0[0], silu_f(g0[1]) * u0[1]); w.y = cvt_pk_bf16(silu_f(g0[2]) * u0[2], silu_f(g0[3]) * u0[3]);
                w.z = cvt_pk_bf16(silu_f(g1[0]) * u1[0], silu_f(g1[1]) * u1[1]); w.w = cvt_pk_bf16(silu_f(g1[2]) * u1[2], silu_f(g1[3]) * u1[3]);
                *(u32x4*)rowp = w;
            }
    }
};

struct EpiResid {
    static constexpr bool PERM = false, AFTER_DRAIN = false;
    const float* xin; float* out; const float* gmod; float alpha, coef; int seq, modstride;
    __device__ __forceinline__ void operator()(const f32x4 (&acc)[2][2][4][2], const Unit& u, int wr, int wc, int fr, int fq) const {
        const int row0 = u.pm * BM + wr * 64 + fr, col0 = u.pn * BM + wc * 32 + 4 * fq;
        const float* gp = gmod + (size_t)((u.pm * BM) / seq) * modstride;
#pragma unroll
        for (int bj = 0; bj < 2; ++bj)
#pragma unroll
            for (int n = 0; n < 2; ++n) {
                const f32x4 gv = *(const f32x4*)(gp + col0 + bj * HALF + n * 16) * coef;
#pragma unroll
                for (int ai = 0; ai < 2; ++ai)
#pragma unroll
                    for (int m = 0; m < 4; ++m) {
                        const size_t off = (size_t)(row0 + ai * HALF + m * 16) * 1024 + col0 + bj * HALF + n * 16;
                        const f32x4 xv = *(const f32x4*)(xin + off);
                        *(f32x4*)(out + off) = xv * alpha + gv * acc[ai][bj][m][n];
                    }
            }
    }
};

struct EpiInProj {
    static constexpr bool PERM = true, AFTER_DRAIN = false;
    bf16_t *FQ, *FK, *FVT, *RQ, *RK, *RKT, *RVT, *RG; const float* ROT; float lg0, lg1, lg2v, lg3;
    __device__ __forceinline__ void operator()(const f32x4 (&acc)[2][2][4][2], const Unit& u, int wr, int wc, int fr, int fq) const {
        const int t = u.pn >> 1, sub = u.pn & 1;
        const int row0 = u.pm * BM + wr * 64 + fr;
        const int b = (u.pm * BM) >> 12, s0 = (u.pm * BM) & 4095;
        if (t == 0 || t == 1 || t == 6) {
            bf16_t* base = (t == 0) ? FQ : (t == 1) ? FK : RG;
            const float sc = (t == 0) ? 0.125f * 1.4426950408889634f : 1.0f;
            const int col0 = sub * BM + wc * 32 + 8 * fq;
#pragma unroll
            for (int ai = 0; ai < 2; ++ai)
#pragma unroll
                for (int m = 0; m < 4; ++m) { bf16_t* rowp = base + (size_t)(row0 + ai * HALF + m * 16) * 512 + col0;
#pragma unroll
                    for (int bj = 0; bj < 2; ++bj) { f32x4 v0 = acc[ai][bj][m][0], v1 = acc[ai][bj][m][1];
                        if (t == 6) { v0 = (f32x4){silu_f(v0[0]), silu_f(v0[1]), silu_f(v0[2]), silu_f(v0[3])}; v1 = (f32x4){silu_f(v1[0]), silu_f(v1[1]), silu_f(v1[2]), silu_f(v1[3])}; }
                        else { v0 = v0 * sc; v1 = v1 * sc; }
                        u32x4 w; w.x = cvt_pk_bf16(v0[0], v0[1]); w.y = cvt_pk_bf16(v0[2], v0[3]); w.z = cvt_pk_bf16(v1[0], v1[1]); w.w = cvt_pk_bf16(v1[2], v1[3]);
                        *(u32x4*)(rowp + bj * HALF) = w; } }
        } else if (t == 2 || t == 5) {
            bf16_t* base = (t == 2) ? FVT : RVT;
#pragma unroll
            for (int bj = 0; bj < 2; ++bj) {
                const int c0 = sub * BM + bj * HALF + wc * 32 + 8 * fq;
                bf16_t* cp = base + ((size_t)b * 512 + c0) * 4096 + s0 + wr * 64 + fr;
#pragma unroll
                for (int ai = 0; ai < 2; ++ai)
#pragma unroll
                    for (int m = 0; m < 4; ++m) { bf16_t* p = cp + ai * HALF + m * 16;
#pragma unroll
                        for (int n = 0; n < 2; ++n) { const f32x4 v = acc[ai][bj][m][n];
                            const unsigned w0 = cvt_pk_bf16(v[0], v[1]), w1 = cvt_pk_bf16(v[2], v[3]);
                            p[(size_t)(4 * n + 0) * 4096] = (bf16_t)(w0 & 0xffffu); p[(size_t)(4 * n + 1) * 4096] = (bf16_t)(w0 >> 16);
                            p[(size_t)(4 * n + 2) * 4096] = (bf16_t)(w1 & 0xffffu); p[(size_t)(4 * n + 3) * 4096] = (bf16_t)(w1 >> 16); } }
            }
        } else {
            const bool isk = (t == 4);
            const float sc = isk ? 0.08838834764831845f : 1.0f;
            bf16_t* base = isk ? RK : RQ;
            const int d0 = 16 * wc + 4 * fq;
#pragma unroll
            for (int bj = 0; bj < 2; ++bj) {
                const int hh = 2 * sub + bj;
                const float lg2 = (hh == 0) ? lg0 : (hh == 1) ? lg1 : (hh == 2) ? lg2v : lg3;
#pragma unroll
                for (int ai = 0; ai < 2; ++ai)
#pragma unroll
                    for (int m = 0; m < 4; ++m) {
                        const int sl = wr * 64 + ai * HALF + m * 16 + fr, s = s0 + sl;
                        const f32x4 r0 = *(const f32x4*)(ROT + ((size_t)s * 64 + d0) * 2), r1 = *(const f32x4*)(ROT + ((size_t)s * 64 + d0) * 2 + 4);
                        const f32x4 v0 = acc[ai][bj][m][0] * sc, v1 = acc[ai][bj][m][1] * sc;
                        float a[4], c[4];
                        a[0] = v0[0] * r0[0] - v0[1] * r0[1]; c[0] = v0[0] * r0[1] + v0[1] * r0[0];
                        a[1] = v0[2] * r0[2] - v0[3] * r0[3]; c[1] = v0[2] * r0[3] + v0[3] * r0[2];
                        a[2] = v1[0] * r1[0] - v1[1] * r1[1]; c[2] = v1[0] * r1[1] + v1[1] * r1[0];
                        a[3] = v1[2] * r1[2] - v1[3] * r1[3]; c[3] = v1[2] * r1[3] + v1[3] * r1[2];
                        bf16_t* rowp = base + (size_t)(u.pm * BM + sl) * 512 + hh * 128 + d0;
                        u32x2 w; w.x = cvt_pk_bf16(a[0], a[1]); w.y = cvt_pk_bf16(a[2], a[3]); *(u32x2*)rowp = w;
                        w.x = cvt_pk_bf16(c[0], c[1]); w.y = cvt_pk_bf16(c[2], c[3]); *(u32x2*)(rowp + 64) = w;
                        if (isk) {
                            const float dec = __builtin_amdgcn_exp2f(lg2 * (float)(127 - (s & 127)));
                            bf16_t* p = RKT + ((size_t)(b * 4 + hh) * 128 + d0) * 4096 + s;
                            const unsigned x0 = cvt_pk_bf16(a[0] * dec, a[1] * dec), x1 = cvt_pk_bf16(a[2] * dec, a[3] * dec);
                            const unsigned y0 = cvt_pk_bf16(c[0] * dec, c[1] * dec), y1 = cvt_pk_bf16(c[2] * dec, c[3] * dec);
                            p[0] = (bf16_t)(x0 & 0xffffu); p[4096] = (bf16_t)(x0 >> 16); p[2 * 4096] = (bf16_t)(x1 & 0xffffu); p[3 * 4096] = (bf16_t)(x1 >> 16);
                            p += (size_t)64 * 4096;
                            p[0] = (bf16_t)(y0 & 0xffffu); p[4096] = (bf16_t)(y0 >> 16); p[2 * 4096] = (bf16_t)(y1 & 0xffffu); p[3 * 4096] = (bf16_t)(y1 >> 16);
                        }
                    }
            }
        }
    }
};
template <class Epi, class Sched, bool ALIGN_EPI = false, bool SP2 = false>
__device__ __forceinline__ void gemm_phase(PG8_LAS unsigned char* lds, const Gemm g, const Sched& S, const Epi& E, const int wid) {
    const int lane = mk_lane(), tid = wid * 64 + lane, wr = wid >> 2, wc = wid & 3, fr = lane & 15, fq = lane >> 4;
    const int K = g.K, nt = K / BK;
    unsigned voffA[2], voffB[2];
#pragma unroll
    for (int i = 0; i < 2; ++i) { int R, C; stage_rc(tid * 16 + i * 8192, R, C); const int Rb = Epi::PERM ? ((R & ~31) + perm32(R & 31)) : R;
        voffA[i] = (unsigned)(R * K + C) * 2u; voffB[i] = (unsigned)(Rb * K + C) * 2u; }
    const size_t kstep = (size_t)(BK * 2);
    const size_t hstep = (size_t)HALF * K * 2;
    const size_t tstep = 2 * hstep;
    const unsigned ldsw = (unsigned)wid * 1024u;
    const int aoff = lds_byte(wr * 64 + fr, fq * 8), boff = lds_byte(wc * 32 + fr, fq * 8);
#define PG8_SA(b, h) (((b) * 2 + (h)) * HTB)
#define PG8_SB(b, h) ((4 + (b) * 2 + (h)) * HTB)
#define PG8_STAGE(bufoff, gbase, voff) do { _Pragma("unroll") for (int _i = 0; _i < 2; ++_i) \
        __builtin_amdgcn_global_load_lds((const unsigned*)((const char*)(gbase) + (voff)[_i]), (PG8_LAS unsigned*)(lds + (bufoff) + ldsw + _i * 8192), 16, 0, 0); } while (0)
#define PG8_LDA(dst, b, h) do { _Pragma("unroll") for (int m = 0; m < 4; ++m) _Pragma("unroll") for (int k = 0; k < 2; ++k) dst[m][k] = *(const PG8_LAS bf16x8*)(lds + PG8_SA(b, h) + aoff + m * 2048 + k * 1024); } while (0)
#define PG8_LDB(dst, b, h) do { _Pragma("unroll") for (int n = 0; n < 2; ++n) _Pragma("unroll") for (int k = 0; k < 2; ++k) dst[n][k] = *(const PG8_LAS bf16x8*)(lds + PG8_SB(b, h) + boff + n * 2048 + k * 1024); } while (0)
#define PG8_MMA(ai, bj, At, Bt) do { __builtin_amdgcn_s_setprio(1); _Pragma("unroll") for (int m = 0; m < 4; ++m) _Pragma("unroll") for (int n = 0; n < 2; ++n) _Pragma("unroll") for (int k = 0; k < 2; ++k) \
        acc[ai][bj][m][n] = __builtin_amdgcn_mfma_f32_16x16x32_bf16(Bt[n][k], At[m][k], acc[ai][bj][m][n], 0, 0, 0); __builtin_amdgcn_s_setprio(0); } while (0)
#define PG8_WAIT_V(n) asm volatile("s_waitcnt vmcnt(" #n ")" ::: "memory")
#define PG8_WAIT_L(n) asm volatile("s_waitcnt lgkmcnt(" #n ")" ::: "memory")
#define PG8_BAR __builtin_amdgcn_s_barrier()
#define PG8_SCHED __builtin_amdgcn_sched_barrier(0)
    Unit cur, nxt; int ui = 0;
    if (!S.next(0, cur)) return;
    f32x4 acc[2][2][4][2];
#pragma unroll
    for (int a = 0; a < 2; ++a)
#pragma unroll
        for (int b = 0; b < 2; ++b)
#pragma unroll
            for (int m = 0; m < 4; ++m)
#pragma unroll
                for (int n = 0; n < 2; ++n) acc[a][b][m][n] = (f32x4){0.f, 0.f, 0.f, 0.f};
    bf16x8 At[4][2], B0[2][2], B1[2][2];
    const char* cA = (const char*)g.A + (size_t)cur.pm * tstep; const char* cB = (const char*)g.Bt + (size_t)cur.pn * tstep;
    S.a_ready(cur);
    if constexpr (SP2) {
        PG8_STAGE(PG8_SB(0, 0), cB, voffB); PG8_STAGE(PG8_SB(0, 1), cB + hstep, voffB); PG8_STAGE(PG8_SA(0, 0), cA, voffA); PG8_STAGE(PG8_SA(0, 1), cA + hstep, voffA);
        if (wr == 1) PG8_BAR;
        PG8_WAIT_V(2); PG8_BAR;
        PG8_STAGE(PG8_SB(1, 0), cB + kstep, voffB); PG8_STAGE(PG8_SA(1, 0), cA + kstep, voffA); PG8_STAGE(PG8_SB(1, 1), cB + hstep + kstep, voffB);
        PG8_WAIT_V(6); PG8_BAR;
    } else {
        PG8_STAGE(PG8_SB(0, 0), cB, voffB); PG8_STAGE(PG8_SA(0, 0), cA, voffA); PG8_STAGE(PG8_SB(0, 1), cB + hstep, voffB); PG8_STAGE(PG8_SA(0, 1), cA + hstep, voffA);
        if (wr == 1) PG8_BAR;
        PG8_WAIT_V(4); PG8_BAR;
        PG8_STAGE(PG8_SB(1, 0), cB + kstep, voffB); PG8_STAGE(PG8_SA(1, 0), cA + kstep, voffA); PG8_STAGE(PG8_SB(1, 1), cB + hstep + kstep, voffB);
        PG8_WAIT_V(6); PG8_BAR;
    }
    for (;;) {
        const bool has_next = S.next(ui + 1, nxt);
        const char* nA = has_next ? (const char*)g.A + (size_t)nxt.pm * tstep : cA; const char* nB = has_next ? (const char*)g.Bt + (size_t)nxt.pn * tstep : cB;
        for (int t = 0; t < nt; t += 2) {
            const bool last = (t == nt - 2);
            const char* a1 = cA + (size_t)(t + 1) * kstep;
            const char* a2 = last ? nA : cA + (size_t)(t + 2) * kstep; const char* b2 = last ? nB : cB + (size_t)(t + 2) * kstep;
            const char* a3 = a2 + kstep; const char* b3 = b2 + kstep;
            if (last && has_next) S.a_ready(nxt);
            if constexpr (SP2) {
            PG8_LDB(B0, 0, 0); PG8_LDB(B1, 0, 1); PG8_SCHED; PG8_LDA(At, 0, 0); PG8_STAGE(PG8_SA(1, 1), a1 + hstep, voffA);
            PG8_WAIT_V(8); PG8_WAIT_L(0); PG8_BAR; PG8_MMA(0, 0, At, B0); PG8_MMA(0, 1, At, B1); PG8_BAR; PG8_SCHED;
            PG8_LDA(At, 0, 1); PG8_STAGE(PG8_SB(0, 0), b2, voffB); PG8_STAGE(PG8_SB(0, 1), b2 + hstep, voffB); PG8_STAGE(PG8_SA(0, 0), a2, voffA);
            PG8_WAIT_V(8); PG8_WAIT_L(0); PG8_BAR; PG8_MMA(1, 0, At, B0); PG8_MMA(1, 1, At, B1); PG8_BAR; PG8_SCHED;
            PG8_LDB(B0, 1, 0); PG8_LDB(B1, 1, 1); PG8_SCHED; PG8_LDA(At, 1, 0); PG8_STAGE(PG8_SA(0, 1), a2 + hstep, voffA);
            PG8_WAIT_V(8); PG8_WAIT_L(0); PG8_BAR; PG8_MMA(0, 0, At, B0); PG8_MMA(0, 1, At, B1); PG8_BAR; PG8_SCHED;
            PG8_LDA(At, 1, 1); PG8_STAGE(PG8_SB(1, 0), b3, voffB); PG8_STAGE(PG8_SB(1, 1), b3 + hstep, voffB); PG8_STAGE(PG8_SA(1, 0), a3, voffA);
            PG8_WAIT_V(8); PG8_WAIT_L(0); PG8_BAR; PG8_MMA(1, 0, At, B0); PG8_MMA(1, 1, At, B1); PG8_BAR; PG8_SCHED;
            } else {
            PG8_LDB(B0, 0, 0); PG8_SCHED; PG8_LDA(At, 0, 0); PG8_STAGE(PG8_SA(1, 1), a1 + hstep, voffA);
            PG8_WAIT_L(8); PG8_BAR; PG8_WAIT_L(0); PG8_MMA(0, 0, At, B0); PG8_BAR; PG8_SCHED;
            PG8_LDB(B1, 0, 1); PG8_STAGE(PG8_SB(0, 0), b2, voffB);
            PG8_BAR; PG8_WAIT_L(0); PG8_MMA(0, 1, At, B1); PG8_BAR;
            PG8_LDA(At, 0, 1); PG8_STAGE(PG8_SA(0, 0), a2, voffA);
            PG8_BAR; PG8_WAIT_L(0); PG8_MMA(1, 0, At, B0); PG8_BAR; PG8_SCHED;
            PG8_STAGE(PG8_SB(0, 1), b2 + hstep, voffB);
            PG8_WAIT_V(6); PG8_BAR; PG8_MMA(1, 1, At, B1); PG8_BAR;
            PG8_LDB(B0, 1, 0); PG8_SCHED; PG8_LDA(At, 1, 0); PG8_STAGE(PG8_SA(0, 1), a2 + hstep, voffA);
            PG8_WAIT_L(8); PG8_BAR; PG8_WAIT_L(0); PG8_MMA(0, 0, At, B0); PG8_BAR; PG8_SCHED;
            PG8_LDB(B1, 1, 1); PG8_STAGE(PG8_SB(1, 0), b3, voffB);
            PG8_BAR; PG8_WAIT_L(0); PG8_MMA(0, 1, At, B1); PG8_BAR;
            PG8_LDA(At, 1, 1); PG8_STAGE(PG8_SA(1, 0), a3, voffA);
            PG8_BAR; PG8_WAIT_L(0); PG8_MMA(1, 0, At, B0); PG8_BAR; PG8_SCHED;
            PG8_STAGE(PG8_SB(1, 1), b3 + hstep, voffB);
            PG8_WAIT_V(6); PG8_BAR; PG8_MMA(1, 1, At, B1); PG8_BAR;
            }
        }
        if constexpr (ALIGN_EPI) { if (wr == 0) PG8_BAR; }
        if constexpr (!Epi::AFTER_DRAIN) { E(acc, cur, wr, wc, fr, fq); S.done(cur); }
        if (!has_next) break;
#pragma unroll
        for (int a = 0; a < 2; ++a)
#pragma unroll
            for (int b = 0; b < 2; ++b)
#pragma unroll
                for (int m = 0; m < 4; ++m)
#pragma unroll
                    for (int n = 0; n < 2; ++n) acc[a][b][m][n] = (f32x4){0.f, 0.f, 0.f, 0.f};
        cur = nxt; cA = nA; cB = nB; ++ui;
        if constexpr (ALIGN_EPI) { if (wr == 1) PG8_BAR; }
    }
    PG8_WAIT_V(0);
    if constexpr (!ALIGN_EPI) { if (wr == 0) PG8_BAR; }
    PG8_BAR;
    if constexpr (Epi::AFTER_DRAIN) { E.fused(acc, cur, wr, wc, fr, fq, lds, wid, lane); S.done(cur); }
#undef PG8_SA
#undef PG8_SB
#undef PG8_STAGE
#undef PG8_LDA
#undef PG8_LDB
#undef PG8_MMA
#undef PG8_WAIT_V
#undef PG8_WAIT_L
#undef PG8_BAR
#undef PG8_SCHED
}
}
#ifndef MK_N_LAUNCHES
#define MK_N_LAUNCHES 1
#endif
constexpr int NPHASE = 14;
constexpr int BATCH = 4, SEQ = 4096, D = 1024, M = BATCH * SEQ, FF = 2816, NGU = 2 * FF, NIN = 3584, DINP = 3592, NMOD = 9 * D;
constexpr float LN_EPS = 1e-5f, ALPHA = 1.189207115002721f, LOG2E = 1.4426950408889634f;
constexpr int NTHREADS = 512, NWAVES = 8;
constexpr int LDS_BYTES = 147456;
typedef unsigned short bf16;
typedef float f32x4 __attribute__((ext_vector_type(4)));
typedef float f32x16 __attribute__((ext_vector_type(16)));
typedef short bf16x8 __attribute__((ext_vector_type(8)));
typedef short s16x4 __attribute__((ext_vector_type(4)));
typedef unsigned u32x4 __attribute__((ext_vector_type(4)));
typedef unsigned u32x2 __attribute__((ext_vector_type(2)));
#define LAS __attribute__((address_space(3)))
#define LDS_WAIT() asm volatile("s_waitcnt lgkmcnt(0)" ::: "memory")

constexpr size_t MiB = 1u << 20;
constexpr size_t WS_MOD = 4 * MiB, WS_LF = 4 * MiB + 512 * 1024, WS_NB = 5 * MiB, WS_ROT = 6 * MiB;
constexpr size_t WS_WIN = 8 * MiB, WS_WWO = 15 * MiB, WS_WGU2 = 17 * MiB, WS_WD2 = 28 * MiB, WS_WGU1 = 34 * MiB, WS_WD1 = 45 * MiB;
constexpr size_t WS_ST = 34 * MiB;
constexpr size_t WS_H = 51 * MiB, WS_KV = 51 * MiB;
constexpr size_t WS_ACT = 83 * MiB;
constexpr size_t WS_FQ = 83 * MiB, WS_FK = 99 * MiB, WS_FVT = 115 * MiB, WS_RQ = 131 * MiB, WS_RK = 147 * MiB, WS_RKT = 163 * MiB, WS_RVT = 179 * MiB, WS_RG = 195 * MiB, WS_MIX = 211 * MiB;
constexpr size_t WS_END = 243 * MiB;
static_assert(WS_ACT + (size_t)M * FF * 2 <= WS_END && WS_WD1 + (size_t)D * FF * 2 <= WS_H && WS_WGU1 + (size_t)NGU * D * 2 <= WS_WD1 && WS_WD2 + (size_t)D * FF * 2 <= WS_WGU1, "ws map");

__device__ __forceinline__ unsigned f2bf(float f) { unsigned u = __builtin_bit_cast(unsigned, f); return (u + 0x7fffu + ((u >> 16) & 1u)) >> 16; }
__device__ __forceinline__ unsigned pk2(float lo, float hi) { return pg8::cvt_pk_bf16(lo, hi); }
__device__ __forceinline__ float bf2f(unsigned h) { return __builtin_bit_cast(float, h << 16); }
__device__ __forceinline__ float wave_sum(float v) {
#pragma unroll
    for (int o = 1; o < 64; o <<= 1) v += __shfl_xor(v, o);
    return v;
}
__device__ __forceinline__ float sel4(float a, float b, float c, float d, int i) { return i == 0 ? a : i == 1 ? b : i == 2 ? c : d; }

#define GAS __attribute__((address_space(1)))
typedef GAS unsigned gu32;
typedef GAS unsigned long long gu64;
#define RLX_AGENT __ATOMIC_RELAXED, __HIP_MEMORY_SCOPE_AGENT
#define LDS_WAIT() asm volatile("s_waitcnt lgkmcnt(0)" ::: "memory")
#define VM_WAIT() asm volatile("s_waitcnt vmcnt(0)" ::: "memory")
__device__ __forceinline__ unsigned long long rt() { return __builtin_amdgcn_s_memrealtime(); }
#define XB_TMO      128
#define XB_XCNT(j)  (256  + 64 * (j))
#define XB_XSUB(j)  (1280 + 64 * (j))
#define XB_XGEN(j)  (2304 + 64 * (j))
#define XB_TOP      3328
#define XB_TOPGEN   3392
#define XCD_BAR_WORDS 3456
#define XB_SPIN_CAP (1u << 18)

__device__ __forceinline__ unsigned xb_ld(unsigned* p)              { return __hip_atomic_load(p, __ATOMIC_RELAXED, __HIP_MEMORY_SCOPE_AGENT); }
__device__ __forceinline__ unsigned xb_add(unsigned* p, unsigned v) { return __hip_atomic_fetch_add(p, v, __ATOMIC_RELAXED, __HIP_MEMORY_SCOPE_AGENT); }
__device__ __forceinline__ unsigned xb_xcc_id() { return (unsigned)__builtin_amdgcn_s_getreg((3 << 11) | 20) & 0xFu; }
#define XB_SPIN(cond, bar) do { unsigned _sp = 0; while (cond) { __builtin_amdgcn_s_sleep(1); \
    if ((++_sp & 255u) == 0u) { if (xb_ld(&(bar)[XB_TMO])) break; if (_sp > XB_SPIN_CAP) { atomicAdd(&(bar)[XB_TMO], 1u); break; } } } } while (0)

struct XcdBarrier {
    unsigned* bar; unsigned x;
    volatile LAS unsigned* st;
    bool w0;
};

__device__ __forceinline__ XcdBarrier xcd_barrier_post(unsigned* bar, volatile LAS unsigned* st) {
    XcdBarrier b; b.bar = bar; b.x = xb_xcc_id(); b.st = st; b.w0 = (__builtin_amdgcn_readfirstlane(threadIdx.x >> 6) == 0);
    if (threadIdx.x == 0) (void)xb_add(&bar[XB_XCNT(b.x)], 1u);
    return b;
}
__device__ __forceinline__ void xcd_barrier_complete(unsigned* bar, unsigned x, unsigned& nloc, unsigned& nx) {
    const unsigned G = gridDim.x * gridDim.y * gridDim.z;
    unsigned sum, cnt, mine, sp = 0u;
    for (;;) {
        sum = 0u; cnt = 0u; mine = 0u;
#pragma unroll
        for (unsigned j = 0; j < 16; ++j) { const unsigned c = xb_ld(&bar[XB_XCNT(j)]); sum += c; cnt += (c > 0u) ? 1u : 0u; mine = (j == x) ? c : mine; }
        if (sum == G) break;
        __builtin_amdgcn_s_sleep(1);
        if ((++sp & 255u) == 0u) { if (xb_ld(&bar[XB_TMO])) break; if (sp > XB_SPIN_CAP) { atomicAdd(&bar[XB_TMO], 1u); break; } }
    }
    nloc = mine > 0u ? mine : 1u; nx = cnt > 0u ? cnt : 1u;
}

__device__ __forceinline__ void xcd_barrier(const XcdBarrier& b) {
    asm volatile("s_waitcnt vmcnt(0)" ::: "memory");
    __syncthreads();
    if (b.w0 && mk_lane() == 0) {
        unsigned* bar = b.bar;
        __builtin_amdgcn_s_waitcnt(0);
        unsigned nloc = b.st[0], nx = b.st[1];
        if (nloc == 0u) { xcd_barrier_complete(bar, b.x, nloc, nx); b.st[0] = nloc; b.st[1] = nx; }
        const unsigned old = xb_add(&bar[XB_XSUB(b.x)], 1u);
        const unsigned gen = old / nloc;
        if (old + 1u == (gen + 1u) * nloc) {
            __builtin_amdgcn_fence(__ATOMIC_RELEASE, "agent");
            asm volatile("s_waitcnt vmcnt(0)" ::: "memory");
            const unsigned og = xb_add(&bar[XB_TOP], 1u);
            const unsigned tg = og / nx;
            if (og + 1u == (tg + 1u) * nx) xb_add(&bar[XB_TOPGEN], 1u);
            else XB_SPIN(xb_ld(&bar[XB_TOPGEN]) == tg, bar);
            __builtin_amdgcn_fence(__ATOMIC_ACQUIRE, "agent");
            xb_add(&bar[XB_XGEN(b.x)], 1u);
            asm volatile("s_waitcnt vmcnt(0)" ::: "memory");
        } else {
            XB_SPIN(xb_ld(&bar[XB_XGEN(b.x)]) == gen, bar);
            __builtin_amdgcn_fence(__ATOMIC_ACQUIRE, "agent");
            asm volatile("s_waitcnt vmcnt(0)" ::: "memory");
        }
    }
    __syncthreads();
}

__device__ __forceinline__ void transpose_item(const float* W, int ldw, int col0, int k0, bf16* WT, int K, int drow0, int dstride, float* scr, int lane) {
    const int kk = lane >> 3, c4 = (lane & 7) * 4;
    f32x4 v[8];
#pragma unroll
    for (int i = 0; i < 8; ++i) v[i] = *(const f32x4*)(W + (size_t)(k0 + 8 * i + kk) * ldw + col0 + c4);
#pragma unroll
    for (int i = 0; i < 8; ++i) { float* d = scr + (8 * i + kk) * 33 + c4; d[0] = v[i][0]; d[1] = v[i][1]; d[2] = v[i][2]; d[3] = v[i][3]; }
    LDS_WAIT();
    const int c = lane & 7;
#pragma unroll
    for (int j = 0; j < 4; ++j) { const int n = (lane >> 3) + 8 * j; const float* s = scr + (8 * c) * 33 + n;
        u32x4 o; o.x = pk2(s[0 * 33], s[1 * 33]); o.y = pk2(s[2 * 33], s[3 * 33]); o.z = pk2(s[4 * 33], s[5 * 33]); o.w = pk2(s[6 * 33], s[7 * 33]);
        *(u32x4*)(WT + (size_t)(drow0 + dstride * n) * K + k0 + 8 * c) = o; }
    LDS_WAIT();
}
__device__ __forceinline__ void gu_item(const float* Wg, const float* Wu, bf16* WT, int r, float* scr, int lane) {
    const int up = r >= 1408; if (up) r -= 1408;
    const int kb = r / 88, g = r % 88, n0 = 32 * g;
    transpose_item(up ? Wu : Wg, FF, n0, 64 * kb, WT, D, 256 * (n0 >> 7) + (n0 & 127) + (up ? 128 : 0), 1, scr, lane);
}
__device__ __forceinline__ void down_item(const float* Wd, bf16* WT, int r, float* scr, int lane) {
    const int kb = r >> 5, g = r & 31;
    transpose_item(Wd, D, 32 * g, 64 * kb, WT, FF, 32 * g, 1, scr, lane);
}
__device__ __forceinline__ void win_item(const float* Win, bf16* WT, int r, float* scr, int lane) {
    const int kb = r / 112, g = r % 112; int src, dst, stride = 1;
    if (g < 48) { src = 32 * g; dst = 32 * g; }
    else if (g < 80) { const int isk = g >= 64, gg = (g - 48) & 15, head = gg >> 2, half = (gg >> 1) & 1, d0 = 32 * (gg & 1);
        src = (isk ? 2056 : 1544) + head * 128 + half * 64 + d0; dst = (isk ? 2048 : 1536) + head * 128 + 2 * d0 + half; stride = 2; }
    else { src = 8 + 32 * g; dst = 32 * g; }
    transpose_item(Win, DINP, src, 64 * kb, WT, D, dst, stride, scr, lane);
}
__device__ __forceinline__ void mod_item(const float* c, const float* w_ada, const float* b_ada, float* MOD, int it, float* red, int tid, int lane, int wid) {
    float ca[4][2];
#pragma unroll
    for (int b = 0; b < 4; ++b)
#pragma unroll
        for (int hh = 0; hh < 2; ++hh) { const float cv = c[b * D + 128 * wid + 64 * hh + lane]; ca[b][hh] = cv / (1.0f + expf(-cv)); }
    float acc[4] = {0.f, 0.f, 0.f, 0.f};
    const float* wp = w_ada + (size_t)(128 * wid) * NMOD + 64 * it + lane;
#pragma unroll
    for (int hh = 0; hh < 2; ++hh) {
#pragma unroll 32
        for (int kk = 0; kk < 64; ++kk) { const float wv = wp[(size_t)(64 * hh + kk) * NMOD];
#pragma unroll
            for (int b = 0; b < 4; ++b) acc[b] += wv * __builtin_bit_cast(float, __builtin_amdgcn_readlane(__builtin_bit_cast(int, ca[b][hh]), kk)); }
    }
#pragma unroll
    for (int b = 0; b < 4; ++b) red[(wid * 4 + b) * 64 + lane] = acc[b];
    __syncthreads();
    if (tid < 256) { const int b = tid >> 6, l = tid & 63; float s = 0.f;
#pragma unroll
        for (int w = 0; w < 8; ++w) s += red[(w * 4 + b) * 64 + l];
        MOD[b * NMOD + 64 * it + l] = s + b_ada[64 * it + l]; }
    __syncthreads();
}
__device__ __forceinline__ void rot_entry(float* ROT, int i) {
    const int s = i >> 6, d = i & 63;
    const float invf = (float)exp2((double)d * -0.20762050593046014);
    const float ang = (float)s * invf;
    const double a = (double)ang, n = rint(a * 0.6366197723675814);
    double r = fma(-n, 1.5707963267948966, a); r = fma(-n, 6.123233995736766e-17, r);
    const double r2 = r * r;
    const double sn = r * (1.0 + r2 * (-1.0 / 6 + r2 * (1.0 / 120 + r2 * (-1.0 / 5040 + r2 * (1.0 / 362880 + r2 * (-1.0 / 39916800 + r2 * (1.0 / 6227020800.0)))))));
    const double cs = 1.0 + r2 * (-0.5 + r2 * (1.0 / 24 + r2 * (-1.0 / 720 + r2 * (1.0 / 40320 + r2 * (-1.0 / 3628800 + r2 * (1.0 / 479001600.0 + r2 * (-1.0 / 87178291200.0)))))));
    const int q = ((int)n) & 3;
    const double C = (q == 0) ? cs : (q == 1) ? -sn : (q == 2) ? -cs : sn;
    const double S = (q == 0) ? sn : (q == 1) ? cs : (q == 2) ? -sn : -cs;
    ROT[2 * i] = (float)C; ROT[2 * i + 1] = (float)S;
}

__device__ __forceinline__ void modulate_pass(const float* x, const float* MOD, bf16* H, int gw, int NGW, int lane) {
    for (int m = gw; m < M; m += NGW) {
        const float* mod = MOD + (size_t)(m >> 12) * NMOD;
#pragma unroll
        for (int j = 0; j < 4; ++j) { const int col = 4 * lane + 256 * j;
            const f32x4 xv = *(const f32x4*)(x + (size_t)m * D + col), sh = *(const f32x4*)(mod + col), sc = *(const f32x4*)(mod + D + col);
            const f32x4 h = xv * (sc + 1.0f) + sh;
            u32x2 w; w.x = pk2(h[0], h[1]); w.y = pk2(h[2], h[3]); *(u32x2*)(H + (size_t)m * D + col) = w; }
    }
}
template <bool HAS_H, bool HAS_LF>
__device__ __forceinline__ void ln_pass(float* X, const float* g, const float* bt, const float* MOD, int moff, bf16* H, const float* WFs, const float* fox_b, float* LF, int gw, int NGW, int lane) {
    f32x4 gv[4], bv[4];
#pragma unroll
    for (int j = 0; j < 4; ++j) { gv[j] = *(const f32x4*)(g + 4 * lane + 256 * j); bv[j] = *(const f32x4*)(bt + 4 * lane + 256 * j); }
    for (int m = gw; m < M; m += NGW) {
        float* xr = X + (size_t)m * D;
        f32x4 v[4]; float s = 0.f;
#pragma unroll
        for (int j = 0; j < 4; ++j) { v[j] = *(const f32x4*)(xr + 4 * lane + 256 * j); s += (v[j][0] + v[j][1]) + (v[j][2] + v[j][3]); }
        const float mean = wave_sum(s) * (1.f / D); float s2 = 0.f;
#pragma unroll
        for (int j = 0; j < 4; ++j) { v[j] = v[j] - mean; s2 += (v[j][0] * v[j][0] + v[j][1] * v[j][1]) + (v[j][2] * v[j][2] + v[j][3] * v[j][3]); }
        const float rstd = 1.f / sqrtf(wave_sum(s2) * (1.f / D) + LN_EPS);
#pragma unroll
        for (int j = 0; j < 4; ++j) { v[j] = v[j] * rstd * gv[j] + bv[j]; *(f32x4*)(xr + 4 * lane + 256 * j) = v[j]; }
        if (HAS_H) {
            const float* mod = MOD + (size_t)(m >> 12) * NMOD + moff;
#pragma unroll
            for (int j = 0; j < 4; ++j) { const int col = 4 * lane + 256 * j;
                const f32x4 sh = *(const f32x4*)(mod + col), sc = *(const f32x4*)(mod + D + col);
                v[j] = v[j] * (sc + 1.0f) + sh;
                u32x2 w; w.x = pk2(v[j][0], v[j][1]); w.y = pk2(v[j][2], v[j][3]); *(u32x2*)(H + (size_t)m * D + col) = w; }
            if (HAS_LF) {
                float mine = 0.f;
#pragma unroll
                for (int hd = 0; hd < 8; ++hd) { float p = 0.f;
#pragma unroll
                    for (int j = 0; j < 4; ++j) { const f32x4 w = *(const f32x4*)(WFs + hd * D + 4 * lane + 256 * j); p += (v[j][0] * w[0] + v[j][1] * w[1]) + (v[j][2] * w[2] + v[j][3] * w[3]); }
                    p = wave_sum(p); if (lane == hd) mine = p; }
                if (lane < 8) { const float z = mine + fox_b[lane];
                    const float ls = fminf(z, 0.f) - log1pf(expf(-fabsf(z)));
                    LF[((size_t)(m >> 12) * 8 + lane) * SEQ + (m & 4095)] = ls; }
            }
        }
    }
}
__device__ __forceinline__ void cumsum_seq(const float* LF, float* NB, int sq, float* red, int tid, int lane, int wid) {
    const float* p = LF + (size_t)sq * SEQ + 8 * tid;
    const f32x4 a = *(const f32x4*)p, b = *(const f32x4*)(p + 4);
    float e[8]; e[0] = a[0]; e[1] = e[0] + a[1]; e[2] = e[1] + a[2]; e[3] = e[2] + a[3]; e[4] = e[3] + b[0]; e[5] = e[4] + b[1]; e[6] = e[5] + b[2]; e[7] = e[6] + b[3];
    float inc = e[7];
#pragma unroll
    for (int o = 1; o < 64; o <<= 1) { const float t = __shfl_up(inc, o); if (lane >= o) inc += t; }
    if (lane == 63) red[wid] = inc;
    __syncthreads();
    float off = inc - e[7];
    for (int w = 0; w < wid; ++w) off += red[w];
    f32x4 o0, o1;
    o0[0] = -(off + e[0]) * LOG2E; o0[1] = -(off + e[1]) * LOG2E; o0[2] = -(off + e[2]) * LOG2E; o0[3] = -(off + e[3]) * LOG2E;
    o1[0] = -(off + e[4]) * LOG2E; o1[1] = -(off + e[5]) * LOG2E; o1[2] = -(off + e[6]) * LOG2E; o1[3] = -(off + e[7]) * LOG2E;
    float* q = NB + (size_t)sq * SEQ + 8 * tid; *(f32x4*)q = o0; *(f32x4*)(q + 4) = o1;
    __syncthreads();
}

#define MFMA16(a, b, c) __builtin_amdgcn_mfma_f32_16x16x32_bf16((a), (b), (c), 0, 0, 0)
#define MFMA32(a, b, c) __builtin_amdgcn_mfma_f32_32x32x16_bf16((a), (b), (c), 0, 0, 0)
constexpr int TP = 136;
__device__ __forceinline__ void tile_load(u32x4 (&r)[4], const bf16* src, size_t gp, int tid) {
#pragma unroll
    for (int i = 0; i < 4; ++i) r[i] = *(const u32x4*)(src + (size_t)((tid >> 4) + 32 * i) * gp + 8 * (tid & 15));
}
__device__ __forceinline__ void tile_store(bf16* dst, const u32x4 (&r)[4], int tid) {
#pragma unroll
    for (int i = 0; i < 4; ++i) *(u32x4*)(dst + ((tid >> 4) + 32 * i) * TP + 8 * (tid & 15)) = r[i];
}
__device__ __forceinline__ void ret_kv_phase(unsigned char* lds, const bf16* RVT, const bf16* RKT, float* KV, int blk, int G, int tid, int lane, int wid) {
    const int fr = lane & 15, fq = lane >> 4;
    bf16* Vc = (bf16*)lds; bf16* Kc = Vc + 128 * TP;
    u32x4 rv[4], rk[4];
    int u = blk;
    if (u < 512) { tile_load(rv, RVT + (size_t)(u >> 5) * 128 * SEQ + 128 * (u & 31), SEQ, tid); tile_load(rk, RKT + (size_t)(u >> 5) * 128 * SEQ + 128 * (u & 31), SEQ, tid); }
    for (; u < 512; u += G) {
        tile_store(Vc, rv, tid); tile_store(Kc, rk, tid);
        __syncthreads();
        const int un = u + G;
        if (un < 512) { tile_load(rv, RVT + (size_t)(un >> 5) * 128 * SEQ + 128 * (un & 31), SEQ, tid); tile_load(rk, RKT + (size_t)(un >> 5) * 128 * SEQ + 128 * (un & 31), SEQ, tid); }
        bf16x8 af[4];
#pragma unroll
        for (int ks = 0; ks < 4; ++ks) af[ks] = *(const bf16x8*)(Vc + (16 * wid + fr) * TP + 32 * ks + 8 * fq);
        float* out = KV + (size_t)u * 16384 + (16 * wid + fr) * 128 + 4 * fq;
#pragma unroll
        for (int nb = 0; nb < 8; ++nb) { f32x4 acc = {0.f, 0.f, 0.f, 0.f};
#pragma unroll
            for (int ks = 0; ks < 4; ++ks) { const bf16x8 bfv = *(const bf16x8*)(Kc + (16 * nb + fr) * TP + 32 * ks + 8 * fq); acc = MFMA16(bfv, af[ks], acc); }
            *(f32x4*)(out + 16 * nb) = acc; }
        __syncthreads();
    }
}
__device__ __forceinline__ void ret_scan(const float* KV, bf16* ST, int gtid, int NT, float l0, float l1, float l2, float l3) {
    for (int i = gtid; i < 16 * 4096; i += NT) {
        const int bh = i >> 12, e4 = (i & 4095) * 4;
        const float cd = __builtin_amdgcn_exp2f(sel4(l0, l1, l2, l3, bh & 3) * 128.0f);
        f32x4 s = {0.f, 0.f, 0.f, 0.f};
        for (int j = 0; j < 32; ++j) { const size_t o = ((size_t)bh * 32 + j) * 16384 + e4;
            u32x2 w; w.x = pk2(s[0], s[1]); w.y = pk2(s[2], s[3]); *(u32x2*)(ST + o) = w;
            const f32x4 kv = *(const f32x4*)(KV + o); s = s * cd + kv; }
    }
}
__device__ __forceinline__ void ret_out_phase(unsigned char* lds, const bf16* RQ, const bf16* RK, const bf16* RVT, const bf16* ST, const bf16* RG,
                                              const float* gn_g, const float* gn_b, bf16* MIX, float l0, float l1, float l2, float l3, int blk, int G, int tid, int lane, int wid) {
    const int fr = lane & 15, fq = lane >> 4;
    bf16* Kc = (bf16*)lds; bf16* Sc = Kc + 128 * TP; bf16* Vc = Sc + 128 * TP; bf16* Sp = Vc + 128 * TP + wid * (16 * TP);
    u32x4 rk[4], rs[4], rv[4];
    int u = blk;
#define RET_LOAD(uu) do { const int bh_ = (uu) >> 5, ci_ = (uu) & 31; \
        tile_load(rk, RK + ((size_t)(bh_ >> 2) * SEQ + ci_ * 128) * 512 + (bh_ & 3) * 128, 512, tid); \
        tile_load(rs, ST + (size_t)(uu) * 16384, 128, tid); \
        tile_load(rv, RVT + (size_t)bh_ * 128 * SEQ + ci_ * 128, SEQ, tid); } while (0)
    if (u < 512) RET_LOAD(u);
    for (; u < 512; u += G) {
        const int bh = u >> 5, ci = u & 31, b = bh >> 2, h = bh & 3;
        const float lg2 = sel4(l0, l1, l2, l3, h);
        tile_store(Kc, rk, tid); tile_store(Sc, rs, tid); tile_store(Vc, rv, tid);
        const size_t row = (size_t)b * SEQ + ci * 128 + wid * 16 + fr;
        bf16x8 qf[4];
#pragma unroll
        for (int ks = 0; ks < 4; ++ks) qf[ks] = *(const bf16x8*)(RQ + row * 512 + h * 128 + 32 * ks + 8 * fq);
        __syncthreads();
        const int un = u + G;
        if (un < 512) RET_LOAD(un);
        f32x4 acc[8];
#pragma unroll
        for (int nb = 0; nb < 8; ++nb) { acc[nb] = (f32x4){0.f, 0.f, 0.f, 0.f};
#pragma unroll
            for (int ks = 0; ks < 4; ++ks) { const bf16x8 kf = *(const bf16x8*)(Kc + (16 * nb + fr) * TP + 32 * ks + 8 * fq); acc[nb] = MFMA16(kf, qf[ks], acc[nb]); } }
        const int rt = wid * 16 + fr;
#pragma unroll
        for (int nb = 0; nb < 8; ++nb) { const int j0 = 16 * nb + 4 * fq; float v[4];
#pragma unroll
            for (int e = 0; e < 4; ++e) { const int diff = rt - (j0 + e); v[e] = diff >= 0 ? acc[nb][e] * __builtin_amdgcn_exp2f(lg2 * (float)diff) : 0.f; }
            u32x2 w; w.x = pk2(v[0], v[1]); w.y = pk2(v[2], v[3]); *(u32x2*)(Sp + fr * TP + j0) = w; }
        LDS_WAIT();
        bf16x8 sf[4];
#pragma unroll
        for (int ks = 0; ks < 4; ++ks) sf[ks] = *(const bf16x8*)(Sp + fr * TP + 32 * ks + 8 * fq);
        LDS_WAIT();
#pragma unroll
        for (int nb = 0; nb < 8; ++nb) { acc[nb] = (f32x4){0.f, 0.f, 0.f, 0.f};
#pragma unroll
            for (int ks = 0; ks < 4; ++ks) { const bf16x8 bfv = *(const bf16x8*)(Sc + (16 * nb + fr) * TP + 32 * ks + 8 * fq); acc[nb] = MFMA16(bfv, qf[ks], acc[nb]); } }
        const float qd = __builtin_amdgcn_exp2f(lg2 * (float)(rt + 1));
#pragma unroll
        for (int nb = 0; nb < 8; ++nb) { acc[nb] = acc[nb] * qd;
#pragma unroll
            for (int ks = 0; ks < 4; ++ks) { const bf16x8 vf = *(const bf16x8*)(Vc + (16 * nb + fr) * TP + 32 * ks + 8 * fq); acc[nb] = MFMA16(vf, sf[ks], acc[nb]); } }
        float s = 0.f;
#pragma unroll
        for (int nb = 0; nb < 8; ++nb) s += (acc[nb][0] + acc[nb][1]) + (acc[nb][2] + acc[nb][3]);
        s += __shfl_xor(s, 16); s += __shfl_xor(s, 32);
        const float mean = s * (1.f / 128.f); float q = 0.f;
#pragma unroll
        for (int nb = 0; nb < 8; ++nb) { acc[nb] = acc[nb] - mean; q += (acc[nb][0] * acc[nb][0] + acc[nb][1] * acc[nb][1]) + (acc[nb][2] * acc[nb][2] + acc[nb][3] * acc[nb][3]); }
        q += __shfl_xor(q, 16); q += __shfl_xor(q, 32);
        const float rstd = 1.f / sqrtf(q * (1.f / 128.f) + LN_EPS);
#pragma unroll
        for (int nb = 0; nb < 8; ++nb) { const int c = h * 128 + 16 * nb + 4 * fq;
            const f32x4 g = *(const f32x4*)(gn_g + c), bb = *(const f32x4*)(gn_b + c);
            const u32x2 rg = *(const u32x2*)(RG + row * 512 + c);
            const f32x4 gate = {bf2f(rg.x & 0xffffu), bf2f(rg.x >> 16), bf2f(rg.y & 0xffffu), bf2f(rg.y >> 16)};
            const f32x4 o = (acc[nb] * rstd * g + bb) * gate;
            u32x2 w; w.x = pk2(o[0], o[1]); w.y = pk2(o[2], o[3]); *(u32x2*)(MIX + row * 1024 + 512 + c) = w; }
        __syncthreads();
    }
#undef RET_LOAD
}

__device__ __forceinline__ int crow(int r, int hi) { return (r & 3) + 8 * (r >> 2) + 4 * hi; }
constexpr int KP = 72, VP = 68;
constexpr int FOX_K = 0, FOX_V = 2 * 64 * KP * 2, FOX_NB = FOX_V + 2 * 64 * VP * 2;
__device__ __forceinline__ void fox_unit(unsigned char* lds, int b, int h, int qb, const bf16* FQ, const bf16* FK, const bf16* FVT, const float* NBg, bf16* MIX, int tid, int lane, int wid) {
    const int r32 = lane & 31, hi = lane >> 5;
    bf16* Ks = (bf16*)(lds + FOX_K); bf16* Vs = (bf16*)(lds + FOX_V); float* nb = (float*)(lds + FOX_NB);
    const int q0 = qb * 256, NT = 4 * qb + 4;
    { const float* src = NBg + (size_t)(b * 8 + h) * SEQ;
      for (int i = tid * 4; i < q0 + 256; i += NTHREADS * 4) *(f32x4*)(nb + i) = *(const f32x4*)(src + i); }
    const size_t qrow = (size_t)b * SEQ + q0 + wid * 32 + r32;
    bf16x8 qf[4];
#pragma unroll
    for (int d0 = 0; d0 < 4; ++d0) qf[d0] = *(const bf16x8*)(FQ + qrow * 512 + h * 64 + d0 * 16 + hi * 8);
    const int skey = tid >> 3, sch = tid & 7;
    const bf16* kg = FK + ((size_t)b * SEQ + skey) * 512 + h * 64 + sch * 8;
    const bf16* vg = FVT + ((size_t)(b * 8 + h) * 64 + skey) * SEQ + sch * 8;
    u32x4 kr = *(const u32x4*)kg, vr = *(const u32x4*)vg;
    *(u32x4*)(Ks + skey * KP + sch * 8) = kr;
    { u32x2 lo = {vr.x, vr.y}, hi2 = {vr.z, vr.w}; *(u32x2*)(Vs + skey * VP + sch * 8) = lo; *(u32x2*)(Vs + skey * VP + sch * 8 + 4) = hi2; }
    __syncthreads();
    float m_run = -INFINITY, l_run = 0.f;
    f32x16 oT[2]; oT[0] = f32x16{}; oT[1] = f32x16{};
    const int my_last = 4 * qb + (wid >> 1);
    const int qg = q0 + wid * 32 + r32;
    for (int t = 0; t < NT; ++t) {
        const int cur = t & 1;
        if (t + 1 < NT) { kr = *(const u32x4*)(kg + (size_t)(t + 1) * 64 * 512); vr = *(const u32x4*)(vg + (t + 1) * 64); }
        if (t <= my_last) {
            const bf16* Kb = Ks + cur * 64 * KP; const bf16* Vb = Vs + cur * 64 * VP;
            f32x16 p0 = f32x16{}, p1 = f32x16{};
#pragma unroll
            for (int d0 = 0; d0 < 4; ++d0) {
                const bf16x8 a0 = *(const bf16x8*)(Kb + r32 * KP + d0 * 16 + hi * 8), a1 = *(const bf16x8*)(Kb + (32 + r32) * KP + d0 * 16 + hi * 8);
                p0 = MFMA32(a0, qf[d0], p0); p1 = MFMA32(a1, qf[d0], p1); }
            const int kv0 = t * 64;
#pragma unroll
            for (int g = 0; g < 4; ++g) { const f32x4 b0 = *(const f32x4*)(nb + kv0 + 8 * g + 4 * hi), b1 = *(const f32x4*)(nb + kv0 + 32 + 8 * g + 4 * hi);
#pragma unroll
                for (int e = 0; e < 4; ++e) { p0[4 * g + e] += b0[e]; p1[4 * g + e] += b1[e]; } }
            if (t >= 4 * qb) {
#pragma unroll
                for (int r = 0; r < 16; ++r) { const int kv = kv0 + crow(r, hi); if (kv > qg) p0[r] = -INFINITY; if (kv + 32 > qg) p1[r] = -INFINITY; }
            }
            float mx = fmaxf(p0[0], p1[0]);
#pragma unroll
            for (int r = 1; r < 16; ++r) mx = fmaxf(mx, fmaxf(p0[r], p1[r]));
            mx = fmaxf(mx, __shfl_xor(mx, 32));
            const float m_new = fmaxf(m_run, mx);
            const float alpha = __builtin_amdgcn_exp2f(m_run - m_new);
            m_run = m_new;
            float sum = 0.f;
#pragma unroll
            for (int r = 0; r < 16; ++r) { p0[r] = __builtin_amdgcn_exp2f(p0[r] - m_new); p1[r] = __builtin_amdgcn_exp2f(p1[r] - m_new); sum += p0[r] + p1[r]; }
            l_run = l_run * alpha + sum;
#pragma unroll
            for (int r = 0; r < 16; ++r) { oT[0][r] *= alpha; oT[1][r] *= alpha; }
            u32x4 pb[2][2];
#pragma unroll
            for (int ks = 0; ks < 2; ++ks) {
                pb[0][ks] = (u32x4){pk2(p0[8 * ks + 0], p0[8 * ks + 1]), pk2(p0[8 * ks + 2], p0[8 * ks + 3]), pk2(p0[8 * ks + 4], p0[8 * ks + 5]), pk2(p0[8 * ks + 6], p0[8 * ks + 7])};
                pb[1][ks] = (u32x4){pk2(p1[8 * ks + 0], p1[8 * ks + 1]), pk2(p1[8 * ks + 2], p1[8 * ks + 3]), pk2(p1[8 * ks + 4], p1[8 * ks + 5]), pk2(p1[8 * ks + 6], p1[8 * ks + 7])}; }
#pragma unroll
            for (int dblk = 0; dblk < 2; ++dblk)
#pragma unroll
                for (int half = 0; half < 2; ++half)
#pragma unroll
                    for (int ks = 0; ks < 2; ++ks) {
                        const bf16* va = Vb + (32 * dblk + r32) * VP + 32 * half + 16 * ks + 4 * hi;
                        const s16x4 lo = *(const s16x4*)va, hi4 = *(const s16x4*)(va + 8);
                        const bf16x8 A = {lo[0], lo[1], lo[2], lo[3], hi4[0], hi4[1], hi4[2], hi4[3]};
                        oT[dblk] = MFMA32(A, __builtin_bit_cast(bf16x8, pb[half][ks]), oT[dblk]); }
        }
        if (t + 1 < NT) {
            bf16* Kw = Ks + (cur ^ 1) * 64 * KP; bf16* Vw = Vs + (cur ^ 1) * 64 * VP;
            *(u32x4*)(Kw + skey * KP + sch * 8) = kr;
            u32x2 lo = {vr.x, vr.y}, hi2 = {vr.z, vr.w}; *(u32x2*)(Vw + skey * VP + sch * 8) = lo; *(u32x2*)(Vw + skey * VP + sch * 8 + 4) = hi2;
        }
        __syncthreads();
    }
    l_run += __shfl_xor(l_run, 32);
    const float inv = 1.0f / l_run;
    bf16* orow = MIX + qrow * 1024 + h * 64;
#pragma unroll
    for (int dblk = 0; dblk < 2; ++dblk)
#pragma unroll
        for (int g = 0; g < 4; ++g) { u32x2 w; w.x = pk2(oT[dblk][4 * g] * inv, oT[dblk][4 * g + 1] * inv); w.y = pk2(oT[dblk][4 * g + 2] * inv, oT[dblk][4 * g + 3] * inv);
            *(u32x2*)(orow + 32 * dblk + 8 * g + 4 * hi) = w; }
}

struct Args { const float* in[21]; float* out; unsigned char* ws; float lg2g[4]; int ph_lo, ph_hi; };
__global__ void __launch_bounds__(NTHREADS, 2) fwd_megakernel(Args args) {
    extern __shared__ __attribute__((aligned(16))) unsigned char lds[];
    cg::grid_group grid = cg::this_grid();
    const int wid = __builtin_amdgcn_readfirstlane(threadIdx.x >> 6);
    const int G = gridDim.x, blk = blockIdx.x;
    const int gw = blk * NWAVES + wid, NGW = G * NWAVES, NT = G * NTHREADS;
#define TIDS const int lane = mk_lane(), tid = wid * 64 + lane, gtid = blk * NTHREADS + tid; (void)gtid; (void)tid
    unsigned char* ws = args.ws;
    const float* x = args.in[0];
    float* OUT = args.out;
    float* MOD = (float*)(ws + WS_MOD); float* LF = (float*)(ws + WS_LF); float* NB = (float*)(ws + WS_NB); float* ROT = (float*)(ws + WS_ROT);
    bf16* W_IN = (bf16*)(ws + WS_WIN); bf16* W_WO = (bf16*)(ws + WS_WWO); bf16* W_GU2 = (bf16*)(ws + WS_WGU2); bf16* W_D2 = (bf16*)(ws + WS_WD2);
    bf16* W_GU1 = (bf16*)(ws + WS_WGU1); bf16* W_D1 = (bf16*)(ws + WS_WD1); bf16* ST = (bf16*)(ws + WS_ST);
    bf16* H = (bf16*)(ws + WS_H); float* KV = (float*)(ws + WS_KV); bf16* ACT = (bf16*)(ws + WS_ACT);
    bf16* FQ = (bf16*)(ws + WS_FQ); bf16* FK = (bf16*)(ws + WS_FK); bf16* FVT = (bf16*)(ws + WS_FVT); bf16* RQ = (bf16*)(ws + WS_RQ); bf16* RK = (bf16*)(ws + WS_RK);
    bf16* RKT = (bf16*)(ws + WS_RKT); bf16* RVT = (bf16*)(ws + WS_RVT); bf16* RG = (bf16*)(ws + WS_RG); bf16* MIX = (bf16*)(ws + WS_MIX);
    const float l0 = args.lg2g[0], l1 = args.lg2g[1], l2 = args.lg2g[2], l3 = args.lg2g[3];
    const int lo = args.ph_lo, hi = args.ph_hi;
#define IN(k) (lo <= (k) && (k) < hi)
#ifndef PROBE_SYNCS
#define PROBE_SYNCS 1
#endif
#define SEAM(k) do { if (IN(k) && IN((k) + 1)) { for (int _s = 0; _s < PROBE_SYNCS; ++_s) xcd_barrier(bar); } } while (0)
    PG8_LAS unsigned char* ldsp = (PG8_LAS unsigned char*)lds;
    volatile LAS unsigned* bst = (volatile LAS unsigned*)(ldsp + LDS_BYTES - 64);
    if (threadIdx.x < 4) bst[threadIdx.x] = 0u;
    __syncthreads();
    XcdBarrier bar = xcd_barrier_post((unsigned*)ws, bst);
    if (hi > NPHASE) grid.sync();

    if (IN(0)) { TIDS;
        for (int it = blk; it < NMOD / 64; it += G) mod_item(args.in[1], args.in[2], args.in[3], MOD, it, (float*)lds, tid, lane, wid);
        for (int i = gtid; i < SEQ * 64; i += NT) rot_entry(ROT, i);
        float* scr = (float*)(lds + 16384 + wid * 16384);
        constexpr int I_GU = 2816, I_D = 1408, I_IN = 1792, I_WO = 512, NITEMS = 2 * I_GU + 2 * I_D + I_IN + I_WO;
        for (int it = NGW - 1 - gw; it < NITEMS; it += NGW) {
            int r = it;
            if (r < I_GU) { gu_item(args.in[4], args.in[5], W_GU1, r, scr, lane); continue; } r -= I_GU;
            if (r < I_D) { down_item(args.in[6], W_D1, r, scr, lane); continue; } r -= I_D;
            if (r < I_IN) { win_item(args.in[9], W_IN, r, scr, lane); continue; } r -= I_IN;
            if (r < I_WO) { transpose_item(args.in[13], D, 32 * (r & 31), 64 * (r >> 5), W_WO, D, 32 * (r & 31), 1, scr, lane); continue; } r -= I_WO;
            if (r < I_GU) { gu_item(args.in[16], args.in[17], W_GU2, r, scr, lane); continue; } r -= I_GU;
            down_item(args.in[18], W_D2, r, scr, lane);
        }
    }
    SEAM(0);
    if (IN(1)) { TIDS; modulate_pass(x, MOD, H, gw, NGW, lane); }
    SEAM(1);
    if (IN(2)) { pg8::Gemm g{H, W_GU1, M, NGU, D}; pg8::StaticOrder S; S.init(M, NGU, G, blk); pg8::EpiSwiglu E{ACT, FF};
        pg8::gemm_phase<pg8::EpiSwiglu, pg8::StaticOrder, true, true>(ldsp, g, S, E, wid); }
    SEAM(2);
    if (IN(3)) { pg8::Gemm g{ACT, W_D1, M, D, FF}; pg8::StaticOrder S; S.init(M, D, G, blk); pg8::EpiResid E{x, OUT, MOD + 2 * D, ALPHA, 0.5f, SEQ, NMOD};
        pg8::gemm_phase<pg8::EpiResid, pg8::StaticOrder, true, true>(ldsp, g, S, E, wid); }
    SEAM(3);
    if (IN(4)) { TIDS;
        float* WFs = (float*)lds;
        for (int i = tid; i < 8 * D; i += NTHREADS) { const int k = i >> 3, hd = i & 7; WFs[hd * D + k] = args.in[9][(size_t)k * DINP + 1536 + hd]; }
        __syncthreads();
        ln_pass<true, true>(OUT, args.in[7], args.in[8], MOD, 3 * D, H, WFs, args.in[10], LF, gw, NGW, lane);
        __syncthreads();
    }
    SEAM(4);
    if (IN(5)) { TIDS;
        for (int sq = blk; sq < BATCH * 8; sq += G) cumsum_seq(LF, NB, sq, (float*)lds, tid, lane, wid);
        pg8::Gemm g{H, W_IN, M, NIN, D}; pg8::StaticOrder S; S.init(M, NIN, G, blk);
        pg8::EpiInProj E{FQ, FK, FVT, RQ, RK, RKT, RVT, RG, ROT, l0, l1, l2, l3};
        pg8::gemm_phase<pg8::EpiInProj, pg8::StaticOrder, true, true>(ldsp, g, S, E, wid);
    }
    SEAM(5);
    if (IN(6)) { TIDS; ret_kv_phase(lds, RVT, RKT, KV, blk, G, tid, lane, wid); }
    SEAM(6);
    if (IN(7)) { TIDS;
        ret_scan(KV, ST, gtid, NT, l0, l1, l2, l3);
        for (int it = blk; it < 512; it += G) { const int i2 = it & 255, bh = i2 >> 3, s = i2 & 7, qb = (it < 256) ? 15 - s : s;
            fox_unit(lds, bh >> 3, bh & 7, qb, FQ, FK, FVT, NB, MIX, tid, lane, wid); }
    }
    SEAM(7);
    if (IN(8)) { TIDS; ret_out_phase(lds, RQ, RK, RVT, ST, RG, args.in[11], args.in[12], MIX, l0, l1, l2, l3, blk, G, tid, lane, wid); }
    SEAM(8);
    if (IN(9)) { pg8::Gemm g{MIX, W_WO, M, D, D}; pg8::StaticOrder S; S.init(M, D, G, blk); pg8::EpiResid E{OUT, OUT, MOD + 5 * D, ALPHA, 1.0f, SEQ, NMOD};
        pg8::gemm_phase<pg8::EpiResid, pg8::StaticOrder, true, true>(ldsp, g, S, E, wid); }
    SEAM(9);
    if (IN(10)) { TIDS; ln_pass<true, false>(OUT, args.in[14], args.in[15], MOD, 6 * D, H, nullptr, nullptr, nullptr, gw, NGW, lane); }
    SEAM(10);
    if (IN(11)) { pg8::Gemm g{H, W_GU2, M, NGU, D}; pg8::StaticOrder S; S.init(M, NGU, G, blk); pg8::EpiSwiglu E{ACT, FF};
        pg8::gemm_phase<pg8::EpiSwiglu, pg8::StaticOrder, true, true>(ldsp, g, S, E, wid); }
    SEAM(11);
    if (IN(12)) { pg8::Gemm g{ACT, W_D2, M, D, FF}; pg8::StaticOrder S; S.init(M, D, G, blk); pg8::EpiResid E{OUT, OUT, MOD + 8 * D, ALPHA, 0.5f, SEQ, NMOD};
        pg8::gemm_phase<pg8::EpiResid, pg8::StaticOrder, true, true>(ldsp, g, S, E, wid); }
    SEAM(12);
    if (IN(13)) { TIDS; ln_pass<false, false>(OUT, args.in[19], args.in[20], nullptr, 0, nullptr, nullptr, nullptr, nullptr, gw, NGW, lane); }
#undef IN
#undef SEAM
}

extern "C" void kernel_launch(void* const* d_in, const int* in_sizes, int n_in, void* d_out, int out_size, void* d_ws, size_t ws_size, hipStream_t stream) {
    static int grid = 0;
    if (grid == 0) {
        if (n_in != 21 || out_size != M * D || ws_size < WS_END) { fprintf(stderr, "kernel_launch: unexpected problem geometry (n_in %d, out %d, ws %zu)\n", n_in, out_size, ws_size); grid = -1; return; }
        int dev = 0, cus = 0, per_cu = 0;
        hipGetDevice(&dev); hipDeviceGetAttribute(&cus, hipDeviceAttributeMultiprocessorCount, dev);
        if (hipFuncSetAttribute((const void*)fwd_megakernel, hipFuncAttributeMaxDynamicSharedMemorySize, LDS_BYTES) != hipSuccess) { fprintf(stderr, "kernel_launch: hipFuncSetAttribute failed\n"); grid = -1; return; }
        if (hipOccupancyMaxActiveBlocksPerMultiprocessor(&per_cu, (const void*)fwd_megakernel, NTHREADS, LDS_BYTES) != hipSuccess || per_cu < 1) { fprintf(stderr, "kernel_launch: occupancy query says %d\n", per_cu); per_cu = 1; }
        (void)hipGetLastError();
        grid = cus * per_cu;
    }
    if (grid < 0) return;
    if (hipMemsetAsync(d_ws, 0, 16384, stream) != hipSuccess) { fprintf(stderr, "kernel_launch: memset failed\n"); return; }
    Args a{};
    for (int i = 0; i < 21; ++i) a.in[i] = (const float*)d_in[i];
    a.out = (float*)d_out; a.ws = (unsigned char*)d_ws;
    for (int h = 0; h < 4; ++h) a.lg2g[h] = (float)std::log2(1.0 - std::pow(2.0, -5.0 - h));
#if MK_N_LAUNCHES == 1
    a.ph_lo = 0; a.ph_hi = NPHASE;
    void* kargs[] = {&a};
    hipError_t e = hipLaunchCooperativeKernel((const void*)fwd_megakernel, dim3(grid), dim3(NTHREADS), kargs, LDS_BYTES, stream);
    if (e != hipSuccess) fprintf(stderr, "kernel_launch: cooperative launch failed: %s (grid %d)\n", hipGetErrorString(e), grid);
#ifdef PROBE_EXTRA_PHASE
    { Args a2 = a; a2.ph_lo = PROBE_EXTRA_PHASE; a2.ph_hi = PROBE_EXTRA_PHASE + 1; hipLaunchKernelGGL(fwd_megakernel, dim3(grid), dim3(NTHREADS), LDS_BYTES, stream, a2); }
#endif
#else
    for (int p = 0; p < NPHASE; ++p) { a.ph_lo = p; a.ph_hi = p + 1; hipLaunchKernelGGL(fwd_megakernel, dim3(grid), dim3(NTHREADS), LDS_BYTES, stream, a); }
#endif
}
```
